# Optimizing an MI355X kernel written in HIP

```python
import math
import jax, jax.numpy as jnp
from jax import lax
import numpy as np


D_MODEL = 1024
BATCH = 16
SEQ = 2048
DEPTH = 4

HEAD_DIM = 64
BLOCK = 128
DILATED_PAIRS = ((128, 1), (512, 4), (2048, 16))
N_DIL = 3
A_HEADS = 4
A_WIDTH = A_HEADS * HEAD_DIM
A_QKV = 3 * N_DIL * A_HEADS * HEAD_DIM
S5_WIDTH = 256
S5_GROUP_CH = 16
S5_GROUPS = S5_WIDTH // S5_GROUP_CH
S5_STATE = 64
S5_DT_MIN = 1e-3
S5_DT_MAX = 1e-1
C_Q_HEADS = 8
C_KV_HEADS = 2
C_WIDTH = C_Q_HEADS * HEAD_DIM
C_WINDOW = 128
ROPE_THETA = 150000.0
N_BRANCHES = 3
IN_SPLITS = (A_QKV, S5_WIDTH, C_Q_HEADS * HEAD_DIM, C_KV_HEADS * HEAD_DIM, C_KV_HEADS * HEAD_DIM, N_BRANCHES * D_MODEL)
IN_COLS = 6400
D_FF = 3584
N_EXPERTS = 8
TOP_K = 2
N_DENSE = (DEPTH + 1) // 2
N_MOE = DEPTH // 2
RMS_EPS = 1e-6

kernel_name = 'hybrid_gated_dilated_s5_swa_moe'

F32 = jnp.float32


def rmsnorm(x, g):
    xf = x.astype(F32)
    y = xf * lax.rsqrt(jnp.mean(xf * xf, axis=-1, keepdims=True) + RMS_EPS)
    return (y * g.astype(F32)).astype(x.dtype)


def banded_attention(q, k, v, window, sinks=None):
    Bt, L, H, Dh = q.shape
    Hk = k.shape[2]
    rep = H // Hk
    Lp = -(-L // BLOCK) * BLOCK
    nb = Lp // BLOCK
    pad = ((0, 0), (0, Lp - L), (0, 0), (0, 0))
    qb = jnp.pad(q, pad).reshape(Bt, nb, BLOCK, Hk, rep, Dh)
    kb = jnp.pad(k, pad).reshape(Bt, nb, BLOCK, Hk, Dh)
    vb = jnp.pad(v, pad).reshape(Bt, nb, BLOCK, Hk, Dh)

    def with_prev(t):
        prev = jnp.concatenate([jnp.zeros_like(t[:, :1]), t[:, :-1]], axis=1)
        return jnp.concatenate([prev, t], axis=2)

    kw, vw = with_prev(kb), with_prev(vb)
    s = jnp.einsum('bnqgrd,bnkgd->bngrqk', qb, kw, preferred_element_type=F32) * (Dh ** -0.5)
    qi = jnp.arange(BLOCK)[:, None]
    ki = jnp.arange(2 * BLOCK)[None, :]
    dist = BLOCK + qi - ki
    blk = jnp.arange(nb)[:, None, None]
    valid = (dist >= 0) & (dist <= window) & ((blk > 0) | (ki >= BLOCK))
    s = jnp.where(valid[None, :, None, None], s, -jnp.inf)
    m = jnp.max(s, axis=-1)
    if sinks is not None:
        sk = sinks.astype(F32).reshape(1, 1, Hk, rep, 1)
        m = jnp.maximum(m, sk)
    p = jnp.exp(s - m[..., None])
    denom = jnp.sum(p, axis=-1)
    if sinks is not None:
        denom = denom + jnp.exp(sk - m)
    p = p / denom[..., None]
    o = jnp.einsum('bngrqk,bnkgd->bnqgrd', p, vw.astype(F32))
    o = o.reshape(Bt, Lp, H, Dh)[:, :L]
    lse = (m + jnp.log(denom)).transpose(0, 1, 4, 2, 3).reshape(Bt, Lp, H)[:, :L]
    return o, lse


def strided_window_attention(q, k, v, window, dilation):
    Bt, S, H, Dh = q.shape
    L = S // dilation

    def to_phase(t):
        return t.reshape(Bt, L, dilation, H, Dh).transpose(0, 2, 1, 3, 4).reshape(Bt * dilation, L, H, Dh)

    o, lse = banded_attention(to_phase(q), to_phase(k), to_phase(v), window // dilation)
    o = o.reshape(Bt, dilation, L, H, Dh).transpose(0, 2, 1, 3, 4).reshape(Bt, S, H, Dh)
    lse = lse.reshape(Bt, dilation, L, H).transpose(0, 2, 1, 3).reshape(Bt, S, H)
    return o, lse


def dilated_mixer(pa):
    Bt, S, _ = pa.shape
    qkv = pa.reshape(Bt, S, 3, N_DIL, A_HEADS, HEAD_DIM)
    outs, lses = [], []
    for g, (w, d) in enumerate(DILATED_PAIRS):
        o, lse = strided_window_attention(qkv[:, :, 0, g], qkv[:, :, 1, g], qkv[:, :, 2, g], w, d)
        outs.append(o)
        lses.append(lse)
    wts = jax.nn.softmax(jnp.stack(lses, axis=0), axis=0)
    o = jnp.sum(wts[..., None] * jnp.stack(outs, axis=0), axis=0)
    return o.reshape(Bt, S, A_WIDTH).astype(pa.dtype)


def _complex_affine_combine(e1, e2):
    a1r, a1i, b1r, b1i = e1
    a2r, a2i, b2r, b2i = e2
    return (a2r * a1r - a2i * a1i,
            a2r * a1i + a2i * a1r,
            a2r * b1r - a2i * b1i + b2r,
            a2r * b1i + a2i * b1r + b2i)


def s5_mixer(u, lam_re, lam_im, log_dt, b_re, b_im, c_re, c_im, d_skip, w_glu, b_glu):
    Bt, S, W = u.shape
    uf = u.astype(F32)
    ug = uf.reshape(Bt, S, S5_GROUPS, S5_GROUP_CH)
    lr, li = lam_re.astype(F32), lam_im.astype(F32)
    dt = jnp.exp(log_dt.astype(F32))[:, None]
    mag = jnp.exp(lr * dt)
    a_re, a_im = mag * jnp.cos(li * dt), mag * jnp.sin(li * dt)
    nr, ni = a_re - 1.0, a_im
    den = lr * lr + li * li
    z_re = (nr * lr + ni * li) / den
    z_im = (ni * lr - nr * li) / den
    bu_re = jnp.einsum('bsgp,gnp->bsgn', ug, b_re.astype(F32))
    bu_im = jnp.einsum('bsgp,gnp->bsgn', ug, b_im.astype(F32))
    x_re = z_re * bu_re - z_im * bu_im
    x_im = z_re * bu_im + z_im * bu_re
    ar = jnp.broadcast_to(a_re, x_re.shape)
    ai = jnp.broadcast_to(a_im, x_re.shape)
    _, _, h_re, h_im = lax.associative_scan(_complex_affine_combine, (ar, ai, x_re, x_im), axis=1)
    y = (jnp.einsum('bsgn,gpn->bsgp', h_re, c_re.astype(F32))
         - jnp.einsum('bsgn,gpn->bsgp', h_im, c_im.astype(F32)))
    y = y.reshape(Bt, S, W) + d_skip.astype(F32) * uf
    g = jax.nn.gelu(y)
    out = g * jax.nn.sigmoid(g @ w_glu.astype(F32) + b_glu.astype(F32))
    return out.astype(u.dtype)


def rope(x, positions):
    inv = ROPE_THETA ** (-jnp.arange(0, HEAD_DIM, 2, dtype=F32) / HEAD_DIM)
    ang = positions[:, None] * inv[None, :]
    cos, sin = jnp.cos(ang)[None, :, None, :], jnp.sin(ang)[None, :, None, :]
    xf = x.astype(F32)
    x1, x2 = xf[..., :HEAD_DIM // 2], xf[..., HEAD_DIM // 2:]
    return jnp.concatenate([x1 * cos - x2 * sin, x2 * cos + x1 * sin], axis=-1).astype(x.dtype)


def swa_sink_mixer(pq, pk, pv, sinks, positions):
    Bt, S, _ = pq.shape
    q = rope(pq.reshape(Bt, S, C_Q_HEADS, HEAD_DIM), positions)
    k = rope(pk.reshape(Bt, S, C_KV_HEADS, HEAD_DIM), positions)
    v = pv.reshape(Bt, S, C_KV_HEADS, HEAD_DIM)
    o, _ = banded_attention(q, k, v, C_WINDOW, sinks)
    return o.reshape(Bt, S, C_WIDTH).astype(pq.dtype)


def swiglu(h, wg, wu, wd):
    return (jax.nn.silu(h @ wg) * (h @ wu)) @ wd


def moe_swiglu(h, router, wg, wu, wd):
    logits = (h @ router).astype(F32)
    top_v, top_i = lax.top_k(logits, TOP_K)
    top_w = jax.nn.softmax(top_v, axis=-1)
    gate = jnp.sum(jax.nn.one_hot(top_i, N_EXPERTS, dtype=F32) * top_w[..., None], axis=-2)
    out = jnp.zeros_like(h)
    for e in range(N_EXPERTS):
        out = out + gate[..., e:e + 1].astype(h.dtype) * swiglu(h, wg[e], wu[e], wd[e])
    return out


def setup_inputs(seed: int = 0) -> dict:
    key = jax.random.key(seed)
    ks = jax.random.split(key, 32)
    L, D, G, N, P = DEPTH, D_MODEL, S5_GROUPS, S5_STATE, S5_GROUP_CH

    def nrm(k, shape, scale):
        return jax.random.normal(k, shape, F32) * scale

    return {
        'x': nrm(ks[0], (BATCH, SEQ, D), 1.0),
        'norm_mix': 1.0 + nrm(ks[1], (L, D), 0.02),
        'w_in': nrm(ks[2], (L, D, IN_COLS), D ** -0.5),
        's5_lambda_re': -0.5 + nrm(ks[3], (L, G, N), 0.01),
        's5_lambda_im': jnp.pi * jnp.arange(N, dtype=F32) + nrm(ks[4], (L, G, N), 0.01),
        's5_log_dt': jax.random.uniform(ks[5], (L, G), F32, math.log(S5_DT_MIN), math.log(S5_DT_MAX)),
        's5_b_re': nrm(ks[6], (L, G, N, P), (2 * P) ** -0.5),
        's5_b_im': nrm(ks[7], (L, G, N, P), (2 * P) ** -0.5),
        's5_c_re': nrm(ks[8], (L, G, P, N), (2 * N) ** -0.5),
        's5_c_im': nrm(ks[9], (L, G, P, N), (2 * N) ** -0.5),
        's5_d': nrm(ks[10], (L, S5_WIDTH), 1.0),
        's5_w_glu': nrm(ks[11], (L, S5_WIDTH, S5_WIDTH), S5_WIDTH ** -0.5),
        's5_b_glu': nrm(ks[12], (L, S5_WIDTH), 0.02),
        'c_sinks': nrm(ks[13], (L, C_Q_HEADS), 1.0),
        'w_branch_a': nrm(ks[14], (L, A_WIDTH, D), A_WIDTH ** -0.5),
        'w_branch_b': nrm(ks[15], (L, S5_WIDTH, D), S5_WIDTH ** -0.5),
        'w_branch_c': nrm(ks[16], (L, C_WIDTH, D), C_WIDTH ** -0.5),
        'w_out': nrm(ks[17], (L, D, D), D ** -0.5),
        'norm_ffn': 1.0 + nrm(ks[18], (L, D), 0.02),
        'ffn_w_gate': nrm(ks[19], (N_DENSE, D, D_FF), D ** -0.5),
        'ffn_w_up': nrm(ks[20], (N_DENSE, D, D_FF), D ** -0.5),
        'ffn_w_down': nrm(ks[21], (N_DENSE, D_FF, D), D_FF ** -0.5),
        'moe_router': nrm(ks[22], (N_MOE, D, N_EXPERTS), D ** -0.5),
        'moe_w_gate': nrm(ks[23], (N_MOE, N_EXPERTS, D, D_FF), D ** -0.5),
        'moe_w_up': nrm(ks[24], (N_MOE, N_EXPERTS, D, D_FF), D ** -0.5),
        'moe_w_down': nrm(ks[25], (N_MOE, N_EXPERTS, D_FF, D), D_FF ** -0.5),
        'norm_final': 1.0 + nrm(ks[26], (D,), 0.02),
    }


def reference(x, norm_mix, w_in, s5_lambda_re, s5_lambda_im, s5_log_dt, s5_b_re, s5_b_im,
              s5_c_re, s5_c_im, s5_d, s5_w_glu, s5_b_glu, c_sinks, w_branch_a, w_branch_b,
              w_branch_c, w_out, norm_ffn, ffn_w_gate, ffn_w_up, ffn_w_down, moe_router,
              moe_w_gate, moe_w_up, moe_w_down, norm_final):
    Bt, S, D = x.shape
    offsets = [int(o) for o in np.cumsum(IN_SPLITS)[:-1]]
    positions = jnp.arange(S, dtype=F32)
    for l in range(DEPTH):
        h = rmsnorm(x, norm_mix[l])
        proj = h @ w_in[l]
        pa, pb, pq, pk, pv, pg = jnp.split(proj, offsets, axis=-1)
        o_a = dilated_mixer(pa)
        o_b = s5_mixer(pb, s5_lambda_re[l], s5_lambda_im[l], s5_log_dt[l], s5_b_re[l], s5_b_im[l],
                       s5_c_re[l], s5_c_im[l], s5_d[l], s5_w_glu[l], s5_b_glu[l])
        o_c = swa_sink_mixer(pq, pk, pv, c_sinks[l], positions)
        gates = jax.nn.sigmoid(pg.astype(F32)).astype(x.dtype)
        g_a, g_b, g_c = jnp.split(gates, N_BRANCHES, axis=-1)
        merged = (g_a * (o_a @ w_branch_a[l])
                  + g_b * (o_b @ w_branch_b[l])
                  + g_c * (o_c @ w_branch_c[l]))
        x = x + merged @ w_out[l]
        h = rmsnorm(x, norm_ffn[l])
        if l % 2 == 0:
            i = l // 2
            x = x + swiglu(h, ffn_w_gate[i], ffn_w_up[i], ffn_w_down[i])
        else:
            i = l // 2
            x = x + moe_swiglu(h, moe_router[i], moe_w_gate[i], moe_w_up[i], moe_w_down[i])
    return rmsnorm(x, norm_final)
```

```cpp
#include <hip/hip_runtime.h>
#include <cstdio>
#include <cstdint>

#ifndef PROBE_DOUBLE
#define PROBE_DOUBLE 0
#endif
#define PRB(k) (((PROBE_DOUBLE) >> (k)) & 1)
#ifndef FP8_MASK
#define FP8_MASK 0xE
#endif
#ifndef MK_ONE_LAUNCH
#define MK_ONE_LAUNCH 1
#endif

#ifndef IN8_MASK
#define IN8_MASK 0xF
#endif
#ifndef FP8_FULL
#define FP8_FULL 1
#endif
#ifndef PH_MASK
#define PH_MASK 0x1FFF
#endif
#define PHM(k) (((PH_MASK) >> (k)) & 1)
#define LAS __attribute__((address_space(3)))
#define GAS __attribute__((address_space(1)))
typedef unsigned short bf16_t;
typedef short bf16x8 __attribute__((ext_vector_type(8)));
typedef short s16x4 __attribute__((ext_vector_type(4)));
typedef short v4i16_t __attribute__((ext_vector_type(4)));
typedef float f32x2 __attribute__((ext_vector_type(2)));
typedef float f32x4 __attribute__((ext_vector_type(4)));
typedef float f32x16 __attribute__((ext_vector_type(16)));
typedef unsigned u32x2 __attribute__((ext_vector_type(2)));
typedef unsigned u32x4 __attribute__((ext_vector_type(4)));
typedef __bf16 bf16x2_t __attribute__((ext_vector_type(2)));
typedef int v4i32 __attribute__((ext_vector_type(4)));
typedef int v8i32 __attribute__((ext_vector_type(8)));

constexpr int BATCH = 16, SEQ = 2048, DM = 1024, MTOK = BATCH * SEQ, DEPTH = 4;
constexpr int NIN = 6400, DFF = 3584, NEXP = 8;
constexpr int C_QA = 0, C_KA = 768, C_VA = 1536, C_U = 2304, C_QC = 2560, C_KC = 3072, C_VC = 3200, C_G = 3328;
constexpr int S5T = 32, S5NC = SEQ / S5T, S5ROWS = BATCH * S5NC, S5K = 640;
constexpr int MOE_ROWS = 67584;
constexpr float RMS_EPS = 1e-6f;
constexpr int NWAVES = 8, NTHREADS = 512;
constexpr int PPL = 13, NPH = PPL * DEPTH + 1;

constexpr size_t MiB = 1u << 20;
constexpr size_t WS_CTL = 0, CTL_ZERO_BYTES = 1 * MiB;
constexpr size_t WS_ROPE = 1 * MiB;
constexpr size_t WS_AT = 1 * MiB + 512 * 1024;
constexpr size_t WS_TOKE = 2 * MiB, WS_TOKP = 2 * MiB + 256 * 1024, WS_TOKW = 2 * MiB + 512 * 1024;
constexpr size_t WS_LSE = 3 * MiB;
constexpr size_t WS_TOKROW = 5 * MiB;
constexpr size_t WS_BLKCNT = 6 * MiB;
constexpr size_t WS_WIN = 8 * MiB, WS_WBR = 21 * MiB, WS_WOUT = 23 * MiB, WS_WGLU = 25 * MiB, WS_TOEP = 26 * MiB, WS_E = 36 * MiB, WS_WGU = 40 * MiB, WS_WD = 96 * MiB, WS_XB = 124 * MiB;
constexpr size_t WS_H = 208 * MiB;
constexpr size_t WS_PROJ = 272 * MiB, WS_OCAT = 672 * MiB, WS_MERGED = 736 * MiB, WS_U2 = 800 * MiB, WS_SST = 820 * MiB, WS_GACT = 828 * MiB;
constexpr size_t WS_HID = 272 * MiB, WS_Y = 734 * MiB, WS_YPART = 866 * MiB, WS_G8 = 890 * MiB, WS_END = 986 * MiB;
static_assert(WS_WIN + (size_t)NIN * DM * 2 <= WS_WBR && WS_TOEP + (size_t)16 * 512 * S5K * 2 <= WS_E && WS_E + (size_t)16 * 256 * 512 * 2 <= WS_WGU, "ws map 1");
static_assert((FP8_MASK & 0xA) == 0xA, "the ws map holds the MoE FFN weights as fp8 bytes");
static_assert(WS_WGU + (size_t)NEXP * 2 * DFF * DM <= WS_WD && WS_WGU + (size_t)2 * DFF * DM * 2 <= WS_WD && WS_WD + (size_t)NEXP * DM * DFF <= WS_XB && WS_WD + (size_t)DM * DFF * 2 <= WS_XB && WS_XB + (size_t)MTOK * DM * 2 <= WS_H && WS_H + (size_t)MTOK * DM * 2 <= WS_PROJ, "ws map 2");
static_assert(WS_PROJ + (size_t)MTOK * NIN * 2 <= WS_OCAT && WS_U2 + (size_t)16 * S5ROWS * S5K * 2 <= WS_SST && WS_SST + (size_t)16 * S5ROWS * 128 * 4 <= WS_GACT && WS_GACT + (size_t)MTOK * 256 * 2 <= WS_END, "ws map 3");
static_assert(WS_HID + (size_t)MOE_ROWS * DFF * 2 <= WS_Y && WS_Y + (size_t)MOE_ROWS * DM * 2 <= WS_YPART && WS_YPART + (size_t)6 * 2048 * DM * 2 <= WS_G8 && WS_G8 + (size_t)MTOK * 3 * DM <= WS_END, "ws map 4");
constexpr int CW_TMO = 0, CW_MOECNT = 64, CW_BAR = 4096;

constexpr int RING_BYTES = 131072;
constexpr int LDSCTL_OFF = RING_BYTES;
constexpr int LDS_BYTES = 147456;

__device__ __forceinline__ unsigned cvt_pk_bf16(float lo, float hi) { f32x2 v = {lo, hi}; bf16x2_t b = __builtin_convertvector(v, bf16x2_t); return __builtin_bit_cast(unsigned, b); }
__device__ __forceinline__ float bf_lo(unsigned w) { return __uint_as_float(w << 16); }
__device__ __forceinline__ float bf_hi(unsigned w) { return __uint_as_float(w & 0xffff0000u); }
__device__ __forceinline__ u32x4 pack8(const f32x4 a, const f32x4 b) { u32x4 w; w.x = cvt_pk_bf16(a[0], a[1]); w.y = cvt_pk_bf16(a[2], a[3]); w.z = cvt_pk_bf16(b[0], b[1]); w.w = cvt_pk_bf16(b[2], b[3]); return w; }
__device__ __forceinline__ void unpack8(const u32x4 w, f32x4& a, f32x4& b) { a = (f32x4){bf_lo(w.x), bf_hi(w.x), bf_lo(w.y), bf_hi(w.y)}; b = (f32x4){bf_lo(w.z), bf_hi(w.z), bf_lo(w.w), bf_hi(w.w)}; }
__device__ __forceinline__ unsigned pack4_gate(float a, float b, float c, float d) {
    const unsigned w0 = __builtin_bit_cast(unsigned, __builtin_amdgcn_cvt_pknorm_u16(a, b)), w1 = __builtin_bit_cast(unsigned, __builtin_amdgcn_cvt_pknorm_u16(c, d));
    return __builtin_amdgcn_perm(w1, w0, 0x07050301u) | 0x01010101u; }
__device__ __forceinline__ u32x2 pack8_gate(const f32x4 a, const f32x4 b) { u32x2 o; o.x = pack4_gate(a[0], a[1], a[2], a[3]); o.y = pack4_gate(b[0], b[1], b[2], b[3]); return o; }
__device__ __forceinline__ u32x2 pack8_u8(const f32x4 a, const f32x4 b) {
    unsigned q[8];
#pragma unroll
    for (int j = 0; j < 4; ++j) { q[j] = (unsigned)(a[j] + 0.5f); q[4 + j] = (unsigned)(b[j] + 0.5f); }
    u32x2 o; o.x = q[0] | (q[1] << 8) | (q[2] << 16) | (q[3] << 24); o.y = q[4] | (q[5] << 8) | (q[6] << 16) | (q[7] << 24); return o; }
__device__ __forceinline__ void unpack8_u8(const u32x2 w, f32x4& a, f32x4& b) {
    a = (f32x4){(float)(w.x & 255u), (float)((w.x >> 8) & 255u), (float)((w.x >> 16) & 255u), (float)(w.x >> 24)};
    b = (f32x4){(float)(w.y & 255u), (float)((w.y >> 8) & 255u), (float)((w.y >> 16) & 255u), (float)(w.y >> 24)}; }
__device__ __forceinline__ void unpack8_fp8(const u32x2 w, f32x4& a, f32x4& b) {
    const auto a0 = __builtin_amdgcn_cvt_pk_f32_fp8((int)w.x, false), a1 = __builtin_amdgcn_cvt_pk_f32_fp8((int)w.x, true), b0 = __builtin_amdgcn_cvt_pk_f32_fp8((int)w.y, false), b1 = __builtin_amdgcn_cvt_pk_f32_fp8((int)w.y, true);
    a = (f32x4){a0[0], a0[1], a1[0], a1[1]}; b = (f32x4){b0[0], b0[1], b1[0], b1[1]}; }
__device__ __forceinline__ u32x2 pack8_fp8(const f32x4 a, const f32x4 b) {
    f32x4 x = a, y = b;
#pragma unroll
    for (int j = 0; j < 4; ++j) { x[j] = __builtin_amdgcn_fmed3f(x[j], -448.0f, 448.0f); y[j] = __builtin_amdgcn_fmed3f(y[j], -448.0f, 448.0f); }
    int w0 = __builtin_amdgcn_cvt_pk_fp8_f32(x[0], x[1], 0, false); w0 = __builtin_amdgcn_cvt_pk_fp8_f32(x[2], x[3], w0, true);
    int w1 = __builtin_amdgcn_cvt_pk_fp8_f32(y[0], y[1], 0, false); w1 = __builtin_amdgcn_cvt_pk_fp8_f32(y[2], y[3], w1, true);
    u32x2 o; o.x = (unsigned)w0; o.y = (unsigned)w1; return o;
}
__device__ __forceinline__ float sigmoid_f(float x) { return __builtin_amdgcn_rcpf(1.0f + __expf(-x)); }
__device__ __forceinline__ float gelu_tanh_f(float x) { const float z = 0.7978845608f * (x + 0.044715f * x * x * x); const float t = 1.0f - 2.0f * __builtin_amdgcn_rcpf(1.0f + __expf(2.0f * z)); return 0.5f * x * (1.0f + t); }
__device__ __forceinline__ float shfl_xor_l(float v, int mask, int lane) { return __int_as_float(__builtin_amdgcn_ds_bpermute((lane ^ mask) << 2, __float_as_int(v))); }
#define LDS_WAIT() asm volatile("s_waitcnt lgkmcnt(0)" ::: "memory")

namespace pg8 {
#ifndef PG8_WGM
#define PG8_WGM 4
#endif
constexpr int BM = 256, BK = 64, HALF = 128, HTB = HALF * BK * 2, STAGE_BYTES = 8 * HTB, NXCD = 8, WGM = PG8_WGM;
__host__ __device__ __forceinline__ int lds_byte(int r, int c) { const int st = (r >> 4) * 2 + (c >> 5), rr = r & 15, cc = c & 31, ob = rr * 64 + cc * 2; return st * 1024 + (ob ^ (((ob >> 9) & 1) << 5)); }
__host__ __device__ __forceinline__ void stage_rc(int b, int& R, int& C) { const int st = b / 1024, sb = b % 1024, swz = sb ^ (((sb >> 9) & 1) << 5); R = (st >> 1) * 16 + swz / 64; C = (st & 1) * 32 + (swz % 64) / 2; }
__host__ __device__ __forceinline__ int perm32(int rho) { const int n = rho >> 4, i = rho & 15; return 8 * (i >> 2) + 4 * n + (i & 3); }

struct Unit { int pm, pn, koff = 0, nt = 0, ks = 0, pi = 0; };
struct Gemm { const bf16_t* A; const bf16_t* Bt; int lda, ldb, K; };

__device__ __forceinline__ void tile_order(int L, int nM, int nN, int& pm, int& pn) {
    const int nwg = nM * nN; int wgid = L; { const int q = nwg / NXCD, r = nwg % NXCD, xcd = wgid % NXCD, off = wgid / NXCD; wgid = (xcd < r ? xcd * (q + 1) : r * (q + 1) + (xcd - r) * q) + off; }
    const int nig = WGM * nN, gid = wgid / nig, fm = gid * WGM, gsz = (nM - fm) < WGM ? (nM - fm) : WGM;
    pm = fm + ((wgid % nig) % gsz); pn = (wgid % nig) / gsz;
}
template <bool HM> struct GridOrderT { static constexpr bool GATHER = false, SPLITK = false, HALFM = HM; int nM, nN, G, c;
    __device__ __forceinline__ bool next(int i, Unit& u) const { const int L = i * G + c; if (L >= nM * nN) return false; tile_order(L, nM, nN, u.pm, u.pn); return true; } };
using GridOrder = GridOrderT<false>;
struct S5StateOrder { static constexpr bool GATHER = false, SPLITK = false, HALFM = true; int G, c;
    __device__ __forceinline__ bool next(int i, Unit& u) const { const int L = i * G + c; if (L >= 128) return false; u.pm = L; u.pn = L >> 3; return true; } };
struct S5MainOrder { static constexpr bool GATHER = false, SPLITK = false, HALFM = true; int G, c;
    __device__ __forceinline__ bool next(int i, Unit& u) const { const int L = i * G + c; if (L >= 256) return false; const int g = L >> 4, r = L & 15; u.pm = g * 8 + (r & 7); u.pn = g * 2 + (r >> 3); return true; } };
template <bool GATHER_, bool HALFM_ = false> struct FfnOrderT { static constexpr bool GATHER = GATHER_, SPLITK = false, HALFM = HALFM_; static constexpr int RT = HALFM_ ? 128 : 256; int nT, nN, G, c; const LAS int* off; const int* tokrow; int dense;
    __device__ __forceinline__ bool next(int i, Unit& u) const { const int L = i * G + c; if (L >= nT * nN) return false; int pm, pnl; tile_order(L, nT, nN, pm, pnl);
        int e = 0;
#pragma unroll
        for (int k = 1; k < 8; ++k) e += (off[k] <= pm * RT) ? 1 : 0;
        u.pm = pm; u.pn = e * nN + pnl; return true; }
    __device__ __forceinline__ int tok(const Unit& u, int trow) const { const int sr = u.pm * RT + (trow & (RT - 1)); if (dense) return sr; const int e = u.pn / nN, pos = sr - off[e];
        return (pos < off[16 + e]) ? tokrow[(size_t)e * MTOK + pos] : 0; } };
constexpr int DOWN_SPL = 7, DOWN_KSUB = DFF / DOWN_SPL;
struct FfnDownOrder { static constexpr bool GATHER = false, SPLITK = true, HALFM = false; int G, c; const LAS int* mo; int slice_b, full_nt;
    __device__ __forceinline__ bool next(int i, Unit& u) const { const int L = i * G + c; const int nFull = mo[32], np = mo[33]; if (L >= nFull * 4 + np * 4 * DOWN_SPL) return false;
        if (L < nFull * 4) { int fi, pnl; tile_order(L, nFull, 4, fi, pnl); int e = 0;
#pragma unroll
            for (int k = 1; k < 8; ++k) e += (mo[24 + k] <= fi) ? 1 : 0;
            u.pm = (mo[e] >> 8) + (fi - mo[24 + e]); u.pn = e * 4 + pnl; u.koff = 0; u.nt = full_nt; u.ks = 0; u.pi = 0; }
        else { const int j = (int)(L - nFull * 4), ks = j % DOWN_SPL, rest = j / DOWN_SPL, pnl = rest & 3, pi = rest >> 2, e = mo[40 + pi];
            u.pm = (mo[e] >> 8) + (mo[16 + e] >> 8); u.pn = e * 4 + pnl; u.koff = ks * slice_b; u.nt = slice_b / (BK * 2); u.ks = ks; u.pi = pi; }
        return true; } };

struct FfnDownOrderH { static constexpr bool GATHER = false, SPLITK = true, HALFM = true; int G, c; const LAS int* mo; int slice_b, full_nt;
    __device__ __forceinline__ bool next(int i, Unit& u) const { const int L = i * G + c; const int nFullH = 2 * mo[32], npH = 2 * mo[33]; if (L >= nFullH * 4 + npH * 4 * DOWN_SPL) return false;
        if (L < nFullH * 4) { int fh, pnl; tile_order(L, nFullH, 4, fh, pnl); const int fi = fh >> 1; int e = 0;
#pragma unroll
            for (int k = 1; k < 8; ++k) e += (mo[24 + k] <= fi) ? 1 : 0;
            u.pm = ((mo[e] >> 8) + (fi - mo[24 + e])) * 2 + (fh & 1); u.pn = e * 4 + pnl; u.koff = 0; u.nt = full_nt; u.ks = 0; u.pi = 0; }
        else { const int j = (int)(L - nFullH * 4), ks = j % DOWN_SPL, rest = j / DOWN_SPL, pnl = rest & 3, ph = rest >> 2, e = mo[40 + (ph >> 1)];
            u.pm = ((mo[e] >> 8) + (mo[16 + e] >> 8)) * 2 + (ph & 1); u.pn = e * 4 + pnl; u.koff = ks * slice_b; u.nt = slice_b / (BK * 2); u.ks = ks; u.pi = ph; }
        return true; } };

template <class Epi, class Sched>
__device__ __forceinline__ void gemm_phase(LAS unsigned char* lds, const int tid, const Gemm g, const Sched& S, const Epi& E) {
    const int wid = __builtin_amdgcn_readfirstlane(tid >> 6), lane = tid & 63, wr = wid >> 2, wc = wid & 3, fr = lane & 15, fq = lane >> 4;
    const int K = g.K, nt = K / BK;
    unsigned voffA[2], voffB[2];
#pragma unroll
    for (int i = 0; i < 2; ++i) { int R, C; stage_rc(tid * 16 + i * 8192, R, C); const int Rb = Epi::PERM ? ((R & ~31) + perm32(R & 31)) : R;
        voffA[i] = (unsigned)(R * g.lda + C) * 2u; voffB[i] = (unsigned)(Rb * g.ldb + C) * 2u; }
    const size_t kstep = (size_t)(BK * 2);
    const size_t hstepA = (size_t)HALF * g.lda * 2, hstepB = (size_t)HALF * g.ldb * 2;
    static_assert(Epi::HALFM == Sched::HALFM, "half-tile epilogue and order go together");
    const size_t tstepA = Sched::GATHER ? 0 : (Sched::HALFM ? hstepA : 2 * hstepA), tstepB = 2 * hstepB;
    int gR[2], gC[2];
#pragma unroll
    for (int i = 0; i < 2; ++i) stage_rc(tid * 16 + i * 8192, gR[i], gC[i]);
    unsigned vA0[2], vA1[2], vN0[2], vN1[2];
#define PG8_GOFF(U, d0, d1) do { _Pragma("unroll") for (int _i = 0; _i < 2; ++_i) { \
        d0[_i] = (unsigned)((size_t)S.tok(U, gR[_i]) * g.lda + gC[_i]) * 2u; d1[_i] = (unsigned)((size_t)S.tok(U, HALF + gR[_i]) * g.lda + gC[_i]) * 2u; } } while (0)
#define PG8_STAGE_A(bufoff, base, half, v0, v1) do { if constexpr (Sched::GATHER) { if (half) PG8_STAGE(bufoff, base, v1); else PG8_STAGE(bufoff, base, v0); } \
        else { PG8_STAGE(bufoff, (base) + (half) * hstepA, voffA); } } while (0)
    const unsigned ldsw = (unsigned)wid * 1024u;
    const int aoff = lds_byte(wr * 64 + fr, fq * 8), boff = lds_byte(wc * 32 + fr, fq * 8);
#define PG8_SA(b, h) (((b) * 2 + (h)) * HTB)
#define PG8_SB(b, h) ((4 + (b) * 2 + (h)) * HTB)
#define PG8_STAGE(bufoff, gbase, voff) do { _Pragma("unroll") for (int _i = 0; _i < 2; ++_i) \
        __builtin_amdgcn_global_load_lds((const unsigned*)((const char*)(gbase) + (voff)[_i]), (LAS unsigned*)(lds + (bufoff) + ldsw + _i * 8192), 16, 0, 0); } while (0)
#define PG8_LDA(dst, b, h) do { _Pragma("unroll") for (int m = 0; m < 4; ++m) _Pragma("unroll") for (int k = 0; k < 2; ++k) dst[m][k] = *(const LAS bf16x8*)(lds + PG8_SA(b, h) + aoff + m * 2048 + k * 1024); } while (0)
#define PG8_LDB(dst, b, h) do { _Pragma("unroll") for (int n = 0; n < 2; ++n) _Pragma("unroll") for (int k = 0; k < 2; ++k) dst[n][k] = *(const LAS bf16x8*)(lds + PG8_SB(b, h) + boff + n * 2048 + k * 1024); } while (0)
#define PG8_MMA(ai, bj, At, Bt) do { __builtin_amdgcn_s_setprio(1); \
        if constexpr (Epi::FP8) { _Pragma("unroll") for (int m = 0; m < 4; ++m) _Pragma("unroll") for (int n = 0; n < 2; ++n) \
            asm volatile("v_mfma_scale_f32_16x16x128_f8f6f4 %0, %1, %2, %0, %3, %3 op_sel_hi:[0,0,0]" : "+v"(acc[ai][bj][m][n]) : "v"(__builtin_shufflevector(__builtin_bit_cast(v4i32, Bt[n][0]), __builtin_bit_cast(v4i32, Bt[n][1]), 0, 1, 2, 3, 4, 5, 6, 7)), \
                "v"(__builtin_shufflevector(__builtin_bit_cast(v4i32, At[m][0]), __builtin_bit_cast(v4i32, At[m][1]), 0, 1, 2, 3, 4, 5, 6, 7)), "v"(0x7f7f7f7f)); } \
        else { _Pragma("unroll") for (int m = 0; m < 4; ++m) _Pragma("unroll") for (int n = 0; n < 2; ++n) _Pragma("unroll") for (int k = 0; k < 2; ++k) \
            acc[ai][bj][m][n] = __builtin_amdgcn_mfma_f32_16x16x32_bf16(Bt[n][k], At[m][k], acc[ai][bj][m][n], 0, 0, 0); } \
        __builtin_amdgcn_s_setprio(0); } while (0)
#define PG8_WAIT_V(n) asm volatile("s_waitcnt vmcnt(" #n ")" ::: "memory")
#define PG8_WAIT_L(n) asm volatile("s_waitcnt lgkmcnt(" #n ")" ::: "memory")
#define PG8_BAR __builtin_amdgcn_s_barrier()
#define PG8_SCHED __builtin_amdgcn_sched_barrier(0)
    Unit cur, nxt; int ui = 0;
    if (!S.next(0, cur)) return;
    f32x4 acc[2][2][4][2];
#pragma unroll
    for (int a = 0; a < 2; ++a)
#pragma unroll
        for (int b = 0; b < 2; ++b)
#pragma unroll
            for (int m = 0; m < 4; ++m)
#pragma unroll
                for (int n = 0; n < 2; ++n) acc[a][b][m][n] = (f32x4){0.f, 0.f, 0.f, 0.f};
    bf16x8 At[4][2], B0[2][2], B1[2][2];
    const char* cA = (const char*)g.A + (size_t)cur.pm * tstepA; const char* cB = (const char*)g.Bt + (size_t)cur.pn * tstepB;
    if constexpr (Sched::SPLITK) { cA += cur.koff; cB += cur.koff; }
    if constexpr (Sched::GATHER) { PG8_GOFF(cur, vA0, vA1); }
    PG8_STAGE(PG8_SB(0, 0), cB, voffB); PG8_STAGE(PG8_SB(0, 1), cB + hstepB, voffB); PG8_STAGE_A(PG8_SA(0, 0), cA, 0, vA0, vA1); if constexpr (!Epi::HALFM) { PG8_STAGE_A(PG8_SA(0, 1), cA, 1, vA0, vA1); }
    if (wr == 1) PG8_BAR;
    if constexpr (Epi::HALFM) { PG8_WAIT_V(0); } else { PG8_WAIT_V(2); } PG8_BAR;
    PG8_STAGE(PG8_SB(1, 0), cB + kstep, voffB); PG8_STAGE_A(PG8_SA(1, 0), cA + kstep, 0, vA0, vA1); PG8_STAGE(PG8_SB(1, 1), cB + hstepB + kstep, voffB);
    PG8_WAIT_V(6); PG8_BAR;
    for (;;) {
        const bool has_next = S.next(ui + 1, nxt);
        const char* nA = has_next ? (const char*)g.A + (size_t)nxt.pm * tstepA : cA; const char* nB = has_next ? (const char*)g.Bt + (size_t)nxt.pn * tstepB : cB;
        if constexpr (Sched::SPLITK) { if (has_next) { nA += nxt.koff; nB += nxt.koff; } }
        const int unt = Sched::SPLITK ? cur.nt : nt;
        if constexpr (Sched::GATHER) { if (has_next) { PG8_GOFF(nxt, vN0, vN1); } else {
#pragma unroll
            for (int _i = 0; _i < 2; ++_i) { vN0[_i] = vA0[_i]; vN1[_i] = vA1[_i]; } } }
#pragma unroll 1
        for (int t = 0; t < unt; t += 2) {
            const bool last = (t == unt - 2);
            const char* a1 = cA + (size_t)(t + 1) * kstep;
            const char* a2 = last ? nA : cA + (size_t)(t + 2) * kstep; const char* b2 = last ? nB : cB + (size_t)(t + 2) * kstep;
            const char* a3 = a2 + kstep; const char* b3 = b2 + kstep;
            unsigned s0[2], s1[2];
            if constexpr (Sched::GATHER) {
#pragma unroll
                for (int _i = 0; _i < 2; ++_i) { s0[_i] = last ? vN0[_i] : vA0[_i]; s1[_i] = last ? vN1[_i] : vA1[_i]; } }
            PG8_LDB(B0, 0, 0); PG8_LDB(B1, 0, 1); PG8_SCHED; PG8_LDA(At, 0, 0); if constexpr (!Epi::HALFM) { PG8_STAGE_A(PG8_SA(1, 1), a1, 1, vA0, vA1); }
            PG8_WAIT_V(8); PG8_WAIT_L(0); PG8_BAR; PG8_MMA(0, 0, At, B0); if constexpr (!Epi::HALFM) { PG8_MMA(0, 1, At, B1); } PG8_BAR; PG8_SCHED;
            if constexpr (!Epi::HALFM) { PG8_LDA(At, 0, 1); } PG8_STAGE(PG8_SB(0, 0), b2, voffB); PG8_STAGE(PG8_SB(0, 1), b2 + hstepB, voffB); PG8_STAGE_A(PG8_SA(0, 0), a2, 0, s0, s1);
            if constexpr (Epi::HALFM) { PG8_WAIT_V(6); } else { PG8_WAIT_V(8); } PG8_WAIT_L(0); PG8_BAR; if constexpr (!Epi::HALFM) { PG8_MMA(1, 0, At, B0); PG8_MMA(1, 1, At, B1); } else { PG8_MMA(0, 1, At, B1); } PG8_BAR; PG8_SCHED;
            PG8_LDB(B0, 1, 0); PG8_LDB(B1, 1, 1); PG8_SCHED; PG8_LDA(At, 1, 0); if constexpr (!Epi::HALFM) { PG8_STAGE_A(PG8_SA(0, 1), a2, 1, s0, s1); }
            PG8_WAIT_V(8); PG8_WAIT_L(0); PG8_BAR; PG8_MMA(0, 0, At, B0); if constexpr (!Epi::HALFM) { PG8_MMA(0, 1, At, B1); } PG8_BAR; PG8_SCHED;
            if constexpr (!Epi::HALFM) { PG8_LDA(At, 1, 1); } PG8_STAGE(PG8_SB(1, 0), b3, voffB); PG8_STAGE(PG8_SB(1, 1), b3 + hstepB, voffB); PG8_STAGE_A(PG8_SA(1, 0), a3, 0, s0, s1);
            if constexpr (Epi::HALFM) { PG8_WAIT_V(6); } else { PG8_WAIT_V(8); } PG8_WAIT_L(0); PG8_BAR; if constexpr (!Epi::HALFM) { PG8_MMA(1, 0, At, B0); PG8_MMA(1, 1, At, B1); } else { PG8_MMA(0, 1, At, B1); } PG8_BAR; PG8_SCHED;
            if constexpr (Epi::HAS_MID) { if (t + 2 == Epi::MID1 || t + 2 == Epi::MID2) E.mid(acc, cur, wr, wc, fr, fq, (t + 2 == Epi::MID2) ? 1 : 0); }
        }
        if (wr == 0) PG8_BAR;
        E(acc, cur, wr, wc, fr, fq);
        if (!has_next) break;
#pragma unroll
        for (int a = 0; a < 2; ++a)
#pragma unroll
            for (int b = 0; b < 2; ++b)
#pragma unroll
                for (int m = 0; m < 4; ++m)
#pragma unroll
                    for (int n = 0; n < 2; ++n) acc[a][b][m][n] = (f32x4){0.f, 0.f, 0.f, 0.f};
        cur = nxt; cA = nA; cB = nB; ++ui;
        if constexpr (Sched::GATHER) {
#pragma unroll
            for (int _i = 0; _i < 2; ++_i) { vA0[_i] = vN0[_i]; vA1[_i] = vN1[_i]; } }
        if (wr == 1) PG8_BAR;
    }
    PG8_WAIT_V(0);
    PG8_BAR;
#undef PG8_GOFF
#undef PG8_STAGE_A
#undef PG8_SA
#undef PG8_SB
#undef PG8_STAGE
#undef PG8_LDA
#undef PG8_LDB
#undef PG8_MMA
#undef PG8_WAIT_V
#undef PG8_WAIT_L
#undef PG8_BAR
#undef PG8_SCHED
}

struct EpiBf16Plain {
    static constexpr bool PERM = true, HAS_MID = false, FP8 = false, HALFM = false; static constexpr int MID1 = -1, MID2 = -1;
    bf16_t* O; int ldc; int nNl; bf16_t* part;
    __device__ __forceinline__ void operator()(const f32x4 (&acc)[2][2][4][2], const Unit& u, int wr, int wc, int fr_in, int fq) const {
        int fr = fr_in; asm volatile("" : "+v"(fr));
        const int rt0 = wr * 64 + fr, col0 = (u.pn % nNl) * BM + wc * 32 + 8 * fq;
        bf16_t* base = (u.ks == 0) ? O + (size_t)(u.pm * BM + rt0) * ldc : part + (size_t)((u.ks - 1) * 2048 + u.pi * 256 + rt0) * ldc;
#pragma unroll
        for (int ai = 0; ai < 2; ++ai)
#pragma unroll
            for (int m = 0; m < 4; ++m) { bf16_t* rowp = base + (size_t)(ai * HALF + m * 16) * ldc + col0;
#pragma unroll
                for (int bj = 0; bj < 2; ++bj) *(u32x4*)(rowp + bj * HALF) = pack8(acc[ai][bj][m][0], acc[ai][bj][m][1]); }
    }
};
struct EpiSwiGLU {
    static constexpr bool PERM = true, HAS_MID = false, FP8 = false, HALFM = false; static constexpr int MID1 = -1, MID2 = -1;
    bf16_t* Hd; int nNl;
    __device__ __forceinline__ void operator()(const f32x4 (&acc)[2][2][4][2], const Unit& u, int wr, int wc, int fr_in, int fq) const {
        int fr = fr_in; asm volatile("" : "+v"(fr));
        const int row0 = u.pm * BM + wr * 64 + fr, col0 = (u.pn % nNl) * HALF + wc * 32 + 8 * fq;
#pragma unroll
        for (int ai = 0; ai < 2; ++ai)
#pragma unroll
            for (int m = 0; m < 4; ++m) { f32x4 o[2];
#pragma unroll
                for (int n = 0; n < 2; ++n)
#pragma unroll
                    for (int j = 0; j < 4; ++j) { const float gt = acc[ai][0][m][n][j], up = acc[ai][1][m][n][j]; o[n][j] = gt * sigmoid_f(gt) * up; }
                *(u32x4*)(Hd + (size_t)(row0 + ai * HALF + m * 16) * DFF + col0) = pack8(o[0], o[1]); }
    }
};
struct EpiSwiGLU8 {
    static constexpr bool PERM = true, HAS_MID = false, FP8 = true, HALFM = true; static constexpr int MID1 = -1, MID2 = -1;
    unsigned char* Hd; int nNl;
    __device__ __forceinline__ void operator()(const f32x4 (&acc)[2][2][4][2], const Unit& u, int wr, int wc, int fr_in, int fq) const {
        int fr = fr_in; asm volatile("" : "+v"(fr)); asm volatile("s_nop 15\n\ts_nop 15\n\ts_nop 15" ::: "memory");
        const int row0 = u.pm * HALF + wr * 64 + fr, col0 = (u.pn % nNl) * HALF + wc * 32 + 8 * fq;
#pragma unroll
        for (int m = 0; m < 4; ++m) { f32x4 o[2];
#pragma unroll
            for (int n = 0; n < 2; ++n)
#pragma unroll
                for (int j = 0; j < 4; ++j) { const float gt = acc[0][0][m][n][j] * 0.001953125f, up = acc[0][1][m][n][j] * 0.001953125f; o[n][j] = gt * sigmoid_f(gt) * up * 8.0f; }
            *(u32x2*)(Hd + (size_t)(row0 + m * 16) * DFF + col0) = pack8_fp8(o[0], o[1]); }
    }
};
struct EpiSwiGLU8F {
    static constexpr bool PERM = true, HAS_MID = false, FP8 = true, HALFM = false; static constexpr int MID1 = -1, MID2 = -1;
    unsigned char* Hd; int nNl;
    __device__ __forceinline__ void operator()(const f32x4 (&acc)[2][2][4][2], const Unit& u, int wr, int wc, int fr_in, int fq) const {
        int fr = fr_in; asm volatile("" : "+v"(fr)); asm volatile("s_nop 15\n\ts_nop 15\n\ts_nop 15" ::: "memory");
        const int row0 = u.pm * BM + wr * 64 + fr, col0 = (u.pn % nNl) * HALF + wc * 32 + 8 * fq;
#pragma unroll
        for (int ai = 0; ai < 2; ++ai)
#pragma unroll
        for (int m = 0; m < 4; ++m) { f32x4 o[2];
#pragma unroll
            for (int n = 0; n < 2; ++n)
#pragma unroll
                for (int j = 0; j < 4; ++j) { const float ag = acc[ai][0][m][n][j], au = acc[ai][1][m][n][j];
                    const float t = __builtin_amdgcn_exp2f(ag * (-0.001953125f * 1.4426950408889634f)); o[n][j] = (ag * au) * __builtin_amdgcn_rcpf(__builtin_fmaf(t, 32768.0f, 32768.0f)); }
            *(u32x2*)(Hd + (size_t)(row0 + ai * HALF + m * 16) * DFF + col0) = pack8_fp8(o[0], o[1]); }
    }
};
struct EpiBf16Plain8F {
    static constexpr bool PERM = true, HAS_MID = false, FP8 = true, HALFM = false; static constexpr int MID1 = -1, MID2 = -1;
    bf16_t* O; int ldc; int nNl; bf16_t* part;
    __device__ __forceinline__ void operator()(const f32x4 (&acc)[2][2][4][2], const Unit& u, int wr, int wc, int fr_in, int fq) const {
        int fr = fr_in; asm volatile("" : "+v"(fr)); asm volatile("s_nop 15\n\ts_nop 15\n\ts_nop 15" ::: "memory");
        const int rt0 = wr * 64 + fr, col0 = (u.pn % nNl) * BM + wc * 32 + 8 * fq;
        bf16_t* base = (u.ks == 0) ? O + (size_t)(u.pm * BM + rt0) * ldc : part + (size_t)((u.ks - 1) * 2048 + u.pi * 256 + rt0) * ldc;
#pragma unroll
        for (int ai = 0; ai < 2; ++ai)
#pragma unroll
        for (int m = 0; m < 4; ++m) { bf16_t* rowp = base + (size_t)(ai * HALF + m * 16) * ldc + col0;
#pragma unroll
            for (int bj = 0; bj < 2; ++bj) *(u32x4*)(rowp + bj * HALF) = pack8(acc[ai][bj][m][0] * 0.0009765625f, acc[ai][bj][m][1] * 0.0009765625f); }
    }
};
struct EpiBf16Plain8 {
    static constexpr bool PERM = true, HAS_MID = false, FP8 = true, HALFM = true; static constexpr int MID1 = -1, MID2 = -1;
    bf16_t* O; int ldc; int nNl; bf16_t* part;
    __device__ __forceinline__ void operator()(const f32x4 (&acc)[2][2][4][2], const Unit& u, int wr, int wc, int fr_in, int fq) const {
        int fr = fr_in; asm volatile("" : "+v"(fr)); asm volatile("s_nop 15\n\ts_nop 15\n\ts_nop 15" ::: "memory");
        const int rt0 = wr * 64 + fr, col0 = (u.pn % nNl) * BM + wc * 32 + 8 * fq;
        bf16_t* base = (u.ks == 0) ? O + (size_t)(u.pm * HALF + rt0) * ldc : part + (size_t)((u.ks - 1) * 2048 + u.pi * HALF + rt0) * ldc;
#pragma unroll
        for (int m = 0; m < 4; ++m) { bf16_t* rowp = base + (size_t)(m * 16) * ldc + col0;
#pragma unroll
            for (int bj = 0; bj < 2; ++bj) *(u32x4*)(rowp + bj * HALF) = pack8(acc[0][bj][m][0] * 0.0009765625f, acc[0][bj][m][1] * 0.0009765625f); }
    }
};
template <bool F8> struct EpiInProjT {
    static constexpr bool PERM = true, HAS_MID = false, FP8 = F8, HALFM = false; static constexpr int MID1 = -1, MID2 = -1;
    static constexpr float A8 = F8 ? 0.001953125f : 1.0f;
    bf16_t* P; bf16_t* U2; const float* ropec; const float* ropes; unsigned char* G8;
    __device__ __forceinline__ void operator()(const f32x4 (&acc)[2][2][4][2], const Unit& u, int wr, int wc, int fr_in, int fq) const {
        int fr = fr_in; asm volatile("" : "+v"(fr));
        if constexpr (F8) asm volatile("s_nop 15\n\ts_nop 15\n\ts_nop 15" ::: "memory");
        const int pn = u.pn, row0 = u.pm * BM + wr * 64 + fr;
        if (pn == 10 || pn == 11 || (pn == 12 && wc < 2)) {
            const int cbase = (pn == 12) ? (C_KC + wc * 64) : (C_QC + (pn - 10) * 256 + wc * 64);
            const float sc = ((pn == 12) ? 1.0f : 0.125f) * A8;
#pragma unroll
            for (int ai = 0; ai < 2; ++ai)
#pragma unroll
                for (int m = 0; m < 4; ++m) { const int row = row0 + ai * HALF + m * 16, t = row & (SEQ - 1);
                    f32x4 o1[2], o2[2];
#pragma unroll
                    for (int n = 0; n < 2; ++n) { const f32x4 cs = *(const f32x4*)(ropec + t * 32 + 8 * fq + 4 * n), sn = *(const f32x4*)(ropes + t * 32 + 8 * fq + 4 * n);
                        const f32x4 x1 = acc[ai][0][m][n], x2 = acc[ai][1][m][n];
                        o1[n] = (x1 * cs - x2 * sn) * sc; o2[n] = (x2 * cs + x1 * sn) * sc; }
                    bf16_t* rowp = P + (size_t)row * NIN + cbase + 8 * fq;
                    *(u32x4*)(rowp) = pack8(o1[0], o1[1]); *(u32x4*)(rowp + 32) = pack8(o2[0], o2[1]); }
        } else if (pn == 12) {
#pragma unroll
            for (int ai = 0; ai < 2; ++ai)
#pragma unroll
                for (int m = 0; m < 4; ++m) { bf16_t* rowp = P + (size_t)(row0 + ai * HALF + m * 16) * NIN + C_VC + 32 * (wc - 2) + 8 * fq;
#pragma unroll
                    for (int bj = 0; bj < 2; ++bj) *(u32x4*)(rowp + bj * 64) = pack8(acc[ai][bj][m][0] * A8, acc[ai][bj][m][1] * A8); }
        } else if (pn == 9) {
#pragma unroll
            for (int ai = 0; ai < 2; ++ai)
#pragma unroll
                for (int m = 0; m < 4; ++m) { const int row = row0 + ai * HALF + m * 16, b = row >> 11, t = row & (SEQ - 1), c = t >> 5, s = t & 31;
#pragma unroll
                    for (int bj = 0; bj < 2; ++bj) { const int ch0 = bj * HALF + wc * 32 + 8 * fq, gg = ch0 >> 4, q0 = ch0 & 15;
                        *(u32x4*)(U2 + ((size_t)(gg * S5ROWS + b * S5NC + c)) * S5K + s * 16 + q0) = pack8(acc[ai][bj][m][0] * A8, acc[ai][bj][m][1] * A8); } }
        } else {
            const float sc = ((pn < 3) ? 0.125f : 1.0f) * A8; const bool sg = pn >= 13;
            if (sg) {
#pragma unroll
                for (int ai = 0; ai < 2; ++ai)
#pragma unroll
                    for (int m = 0; m < 4; ++m) { unsigned char* rowp = G8 + (size_t)(row0 + ai * HALF + m * 16) * (3 * DM) + (pn - 13) * BM + wc * 32 + 8 * fq;
#pragma unroll
                        for (int bj = 0; bj < 2; ++bj) { f32x4 v0 = acc[ai][bj][m][0], v1 = acc[ai][bj][m][1]; const float c = sc * -1.4426950408889634f;
#pragma unroll
                            for (int j = 0; j < 4; ++j) { v0[j] = __builtin_amdgcn_rcpf(1.0f + __builtin_amdgcn_exp2f(v0[j] * c)); v1[j] = __builtin_amdgcn_rcpf(1.0f + __builtin_amdgcn_exp2f(v1[j] * c)); }
                            __builtin_nontemporal_store(pack8_gate(v0, v1), (u32x2*)(rowp + bj * HALF)); } }
            } else {
#pragma unroll
            for (int ai = 0; ai < 2; ++ai)
#pragma unroll
                for (int m = 0; m < 4; ++m) { bf16_t* rowp = P + (size_t)(row0 + ai * HALF + m * 16) * NIN + pn * BM + wc * 32 + 8 * fq;
#pragma unroll
                    for (int bj = 0; bj < 2; ++bj) { f32x4 v0 = acc[ai][bj][m][0] * sc, v1 = acc[ai][bj][m][1] * sc;
                        *(u32x4*)(rowp + bj * HALF) = pack8(v0, v1); } }
            }
        }
    }
};
using EpiInProj = EpiInProjT<false>;
struct EpiBranch {
    static constexpr bool PERM = true, HAS_MID = true, FP8 = false, HALFM = false; static constexpr int MID1 = 4, MID2 = 8;
    const unsigned char* G8; bf16_t* O;
    __device__ __forceinline__ void mid(f32x4 (&acc)[2][2][4][2], const Unit& u, int wr, int wc, int fr, int fq, int which) const {
        int fr_ = fr; asm volatile("" : "+v"(fr_));
        const int row0 = u.pm * BM + wr * 64 + fr_, col0 = u.pn * BM + wc * 32 + 8 * fq;
        const unsigned char* gp = G8 + (size_t)row0 * (3 * DM) + which * DM + col0;
#pragma unroll
        for (int ai = 0; ai < 2; ++ai) {
            u32x2 wn[4][2], wd[4][2];
#pragma unroll
            for (int m = 0; m < 4; ++m) { const unsigned char* gq = gp + (size_t)(ai * HALF + m * 16) * (3 * DM);
#pragma unroll
                for (int bj = 0; bj < 2; ++bj) { wn[m][bj] = *(const u32x2*)(gq + bj * HALF); wd[m][bj] = *(const u32x2*)(gq + DM + bj * HALF); } }
            asm volatile("" ::: "memory");
#pragma unroll
            for (int m = 0; m < 4; ++m)
#pragma unroll
                for (int bj = 0; bj < 2; ++bj) { f32x4 n0, n1, d0, d1; unpack8_u8(wn[m][bj], n0, n1); unpack8_u8(wd[m][bj], d0, d1);
#pragma unroll
                    for (int j = 0; j < 4; ++j) { acc[ai][bj][m][0][j] *= n0[j] * __builtin_amdgcn_rcpf(d0[j]); acc[ai][bj][m][1][j] *= n1[j] * __builtin_amdgcn_rcpf(d1[j]); } }
            asm volatile("" ::: "memory"); }
    }
    __device__ __forceinline__ void operator()(const f32x4 (&acc)[2][2][4][2], const Unit& u, int wr, int wc, int fr_in, int fq) const {
        int fr = fr_in; asm volatile("" : "+v"(fr));
        const int row0 = u.pm * BM + wr * 64 + fr, col0 = u.pn * BM + wc * 32 + 8 * fq;
        u32x2 wg[2][4][2];
#pragma unroll
        for (int ai = 0; ai < 2; ++ai)
#pragma unroll
            for (int m = 0; m < 4; ++m) { const unsigned char* gp = G8 + (size_t)(row0 + ai * HALF + m * 16) * (3 * DM) + 2 * DM + col0;
#pragma unroll
                for (int bj = 0; bj < 2; ++bj) wg[ai][m][bj] = *(const u32x2*)(gp + bj * HALF); }
        asm volatile("" ::: "memory");
#pragma unroll
        for (int ai = 0; ai < 2; ++ai)
#pragma unroll
            for (int m = 0; m < 4; ++m) { const int row = row0 + ai * HALF + m * 16;
#pragma unroll
                for (int bj = 0; bj < 2; ++bj) { f32x4 g0, g1; unpack8_u8(wg[ai][m][bj], g0, g1);
                    *(u32x4*)(O + (size_t)row * DM + col0 + bj * HALF) = pack8(acc[ai][bj][m][0] * g0 * (1.0f / 256.0f), acc[ai][bj][m][1] * g1 * (1.0f / 256.0f)); } }
    }
};
struct EpiS5State {
    static constexpr bool PERM = false, HAS_MID = false, FP8 = false, HALFM = true; static constexpr int MID1 = -1, MID2 = -1;
    float* Sst;
    __device__ __forceinline__ void operator()(const f32x4 (&acc)[2][2][4][2], const Unit& u, int wr, int wc, int fr_in, int fq) const {
        int fr = fr_in; asm volatile("" : "+v"(fr));
        const int row0 = u.pm * HALF + wr * 64 + fr, col0 = wc * 32 + 4 * fq;
#pragma unroll
            for (int m = 0; m < 4; ++m) { float* rowp = Sst + (size_t)(row0 + m * 16) * 128 + col0;
#pragma unroll
                for (int n = 0; n < 2; ++n) *(f32x4*)(rowp + n * 16) = acc[0][0][m][n]; }
    }
};
struct EpiS5Main {
    static constexpr bool PERM = true, HAS_MID = false, FP8 = false, HALFM = true; static constexpr int MID1 = -1, MID2 = -1;
    const bf16_t* U2; const float* dskip; bf16_t* gact;
    __device__ __forceinline__ void operator()(const f32x4 (&acc)[2][2][4][2], const Unit& u, int wr, int wc, int fr_in, int fq) const {
        int fr = fr_in; asm volatile("" : "+v"(fr));
        const int gg = u.pm >> 3, rl0 = (u.pm & 7) * HALF + wr * 64 + fr, cl0 = (u.pn & 1) * BM + wc * 32 + 8 * fq;
        u32x4 wu[1][4][2];
        constexpr int ai = 0;
#pragma unroll
            for (int m = 0; m < 4; ++m)
#pragma unroll
                for (int bj = 0; bj < 2; ++bj) wu[ai][m][bj] = *(const u32x4*)(U2 + (size_t)(gg * S5ROWS + rl0 + m * 16) * S5K + cl0 + bj * HALF);
        asm volatile("" ::: "memory");
#pragma unroll
            for (int m = 0; m < 4; ++m) { const int rl = rl0 + m * 16, b = rl >> 6, c = rl & 63;
#pragma unroll
                for (int bj = 0; bj < 2; ++bj) { const int col = cl0 + bj * HALF, tau = col >> 4, p0 = col & 15, ch = gg * 16 + p0;
                    f32x4 u0, u1; unpack8(wu[ai][m][bj], u0, u1);
                    const f32x4 d0 = *(const f32x4*)(dskip + ch), d1 = *(const f32x4*)(dskip + ch + 4);
                    f32x4 y0 = acc[ai][bj][m][0] + d0 * u0, y1 = acc[ai][bj][m][1] + d1 * u1;
#pragma unroll
                    for (int j = 0; j < 4; ++j) { y0[j] = gelu_tanh_f(y0[j]); y1[j] = gelu_tanh_f(y1[j]); }
                    *(u32x4*)(gact + (size_t)(b * SEQ + c * S5T + tau) * 256 + ch) = pack8(y0, y1); } }
    }
};
struct EpiGLU {
    static constexpr bool PERM = true, HAS_MID = false, FP8 = false, HALFM = true; static constexpr int MID1 = -1, MID2 = -1;
    const bf16_t* gact; const float* bglu; bf16_t* ocat;
    __device__ __forceinline__ void operator()(const f32x4 (&acc)[2][2][4][2], const Unit& u, int wr, int wc, int fr_in, int fq) const {
        int fr = fr_in; asm volatile("" : "+v"(fr));
        const int row0 = u.pm * HALF + wr * 64 + fr, col0 = wc * 32 + 8 * fq;
        u32x4 wg[1][4][2];
        constexpr int ai = 0;
#pragma unroll
            for (int m = 0; m < 4; ++m)
#pragma unroll
                for (int bj = 0; bj < 2; ++bj) wg[ai][m][bj] = *(const u32x4*)(gact + (size_t)(row0 + m * 16) * 256 + col0 + bj * HALF);
        asm volatile("" ::: "memory");
#pragma unroll
            for (int m = 0; m < 4; ++m) { const int row = row0 + m * 16;
#pragma unroll
                for (int bj = 0; bj < 2; ++bj) { const int col = col0 + bj * HALF;
                    f32x4 g0, g1; unpack8(wg[ai][m][bj], g0, g1);
                    const f32x4 b0 = *(const f32x4*)(bglu + col), b1 = *(const f32x4*)(bglu + col + 4);
                    f32x4 o0, o1;
#pragma unroll
                    for (int j = 0; j < 4; ++j) { o0[j] = g0[j] * sigmoid_f(acc[ai][bj][m][0][j] + b0[j]); o1[j] = g1[j] * sigmoid_f(acc[ai][bj][m][1][j] + b1[j]); }
                    *(u32x4*)(ocat + (size_t)row * DM + 256 + col) = pack8(o0, o1); } }
    }
};
}

#define XB_TMO      128
#define XB_XCNT(j)  (256  + 64 * (j))
#define XB_XSUB(j)  (1280 + 64 * (j))
#define XB_XGEN(j)  (2304 + 64 * (j))
#define XB_TOP      3328
#define XB_TOPGEN   3392
#define XCD_BAR_WORDS 3456
#define XB_SPIN_CAP (1u << 18)

__device__ __forceinline__ unsigned xb_ld(unsigned* p)              { return __hip_atomic_load(p, __ATOMIC_RELAXED, __HIP_MEMORY_SCOPE_AGENT); }
__device__ __forceinline__ unsigned xb_add(unsigned* p, unsigned v) { return __hip_atomic_fetch_add(p, v, __ATOMIC_RELAXED, __HIP_MEMORY_SCOPE_AGENT); }
__device__ __forceinline__ unsigned xb_xcc_id() { return (unsigned)__builtin_amdgcn_s_getreg((3 << 11) | 20) & 0xFu; }
#define XB_SPIN(cond, bar) do { unsigned _sp = 0; while (cond) { __builtin_amdgcn_s_sleep(1); \
    if ((++_sp & 255u) == 0u) { if (xb_ld(&(bar)[XB_TMO])) break; if (_sp > XB_SPIN_CAP) { atomicAdd(&(bar)[XB_TMO], 1u); break; } } } } while (0)

struct XcdBarrier {
    unsigned* bar; unsigned x;
    volatile LAS unsigned* st;
};
__device__ __forceinline__ XcdBarrier xcd_barrier_post(unsigned* bar, volatile LAS unsigned* st) {
    XcdBarrier b; b.bar = bar; b.x = xb_xcc_id(); b.st = st;
    if (threadIdx.x == 0) (void)xb_add(&bar[XB_XCNT(b.x)], 1u);
    return b;
}
__device__ __forceinline__ void xcd_barrier_complete(unsigned* bar, unsigned x, unsigned& nloc, unsigned& nx) {
    const unsigned G = gridDim.x * gridDim.y * gridDim.z;
    unsigned sum, cnt, mine, sp = 0u;
    for (;;) {
        sum = 0u; cnt = 0u; mine = 0u;
#pragma unroll
        for (unsigned j = 0; j < 16; ++j) { const unsigned c = xb_ld(&bar[XB_XCNT(j)]); sum += c; cnt += (c > 0u) ? 1u : 0u; mine = (j == x) ? c : mine; }
        if (sum == G) break;
        __builtin_amdgcn_s_sleep(1);
        if ((++sp & 255u) == 0u) { if (xb_ld(&bar[XB_TMO])) break; if (sp > XB_SPIN_CAP) { atomicAdd(&bar[XB_TMO], 1u); break; } }
    }
    nloc = mine > 0u ? mine : 1u; nx = cnt > 0u ? cnt : 1u;
}
__device__ __forceinline__ void xcd_barrier(const XcdBarrier& b, const bool leader_thread) {
    asm volatile("s_waitcnt vmcnt(0)" ::: "memory");
    __syncthreads();
    if (leader_thread) {
        unsigned one = 1u; asm volatile("" : "+s"(one));
        unsigned* bar = b.bar;
        __builtin_amdgcn_s_waitcnt(0);
        unsigned nloc = b.st[0], nx = b.st[1];
        if (nloc == 0u) { xcd_barrier_complete(bar, b.x, nloc, nx); b.st[0] = nloc; b.st[1] = nx; }
        const unsigned old = xb_add(&bar[XB_XSUB(b.x)], one);
        const unsigned gen = old / nloc;
        if (old + 1u == (gen + 1u) * nloc) {
            __builtin_amdgcn_fence(__ATOMIC_RELEASE, "agent");
            asm volatile("s_waitcnt vmcnt(0)" ::: "memory");
            const unsigned og = xb_add(&bar[XB_TOP], one);
            const unsigned tg = og / nx;
            if (og + 1u == (tg + 1u) * nx) xb_add(&bar[XB_TOPGEN], one);
            else XB_SPIN(xb_ld(&bar[XB_TOPGEN]) == tg, bar);
            __builtin_amdgcn_fence(__ATOMIC_ACQUIRE, "agent");
            xb_add(&bar[XB_XGEN(b.x)], one);
            asm volatile("s_waitcnt vmcnt(0)" ::: "memory");
        } else {
            XB_SPIN(xb_ld(&bar[XB_XGEN(b.x)]) == gen, bar);
            __builtin_amdgcn_fence(__ATOMIC_ACQUIRE, "agent");
            asm volatile("s_waitcnt vmcnt(0)" ::: "memory");
        }
    }
    __syncthreads();
}

struct Args { const float* in[27]; float* out; unsigned char* ws; int ph_lo, ph_hi; };
enum { I_X = 0, I_NORM_MIX, I_W_IN, I_LAM_RE, I_LAM_IM, I_LOG_DT, I_B_RE, I_B_IM, I_C_RE, I_C_IM, I_S5D, I_WGLU, I_BGLU, I_SINKS, I_WBA, I_WBB, I_WBC, I_WOUT, I_NORM_FFN,
       I_FG, I_FU, I_FD, I_ROUTER, I_MG, I_MU, I_MD, I_NORM_FINAL };

struct Frame {
    LAS unsigned char* lds;
    volatile LAS unsigned* MISC;
    LAS int* moff;
    unsigned* ctl;
    int tid, lane, wave, G, bid;
    unsigned char* ws;
};

__device__ __forceinline__ const float* inptr(const Frame& F, int i) {
    const volatile LAS unsigned* t = (const volatile LAS unsigned*)(F.lds + LDSCTL_OFF + 1024) + 2 * i;
    const unsigned lo = __builtin_amdgcn_readfirstlane(t[0]), hi = __builtin_amdgcn_readfirstlane(t[1]);
    return (const float*)(const GAS float*)(((unsigned long long)hi << 32) | lo);
}
struct TItem { const float* src; bf16_t* dst; int N, ldw; float sc8; };
__device__ __forceinline__ void titem_load(const TItem& t, float (&v)[32], int lane) {
    const float* p = t.src + (size_t)(lane >> 3) * t.N + 4 * (lane & 7);
#pragma unroll
    for (int i = 0; i < 8; ++i) { const f32x4 q = __builtin_nontemporal_load((const f32x4*)(p + (size_t)(8 * i) * t.N));
        v[4 * i] = q.x; v[4 * i + 1] = q.y; v[4 * i + 2] = q.z; v[4 * i + 3] = q.w; }
}
__device__ __forceinline__ void titem_store(const TItem& t, const float (&v)[32], LAS float* scr, int lane) {
    { LAS float* w = scr + (lane >> 3) * 33 + 4 * (lane & 7);
#pragma unroll
      for (int i = 0; i < 8; ++i) { w[(8 * i) * 33] = v[4 * i]; w[(8 * i) * 33 + 1] = v[4 * i + 1]; w[(8 * i) * 33 + 2] = v[4 * i + 2]; w[(8 * i) * 33 + 3] = v[4 * i + 3]; } }
    LDS_WAIT(); asm volatile("" ::: "memory");
    if (t.sc8 != 0.f) {
        const float q = t.sc8; const int c4 = lane & 3;
#pragma unroll
        for (int j = 0; j < 2; ++j) { const int n = (lane >> 2) + 16 * j; const LAS float* s = scr + (16 * c4) * 33 + n;
            const u32x2 lo = pack8_fp8((f32x4){s[0 * 33] * q, s[1 * 33] * q, s[2 * 33] * q, s[3 * 33] * q}, (f32x4){s[4 * 33] * q, s[5 * 33] * q, s[6 * 33] * q, s[7 * 33] * q});
            const u32x2 hi = pack8_fp8((f32x4){s[8 * 33] * q, s[9 * 33] * q, s[10 * 33] * q, s[11 * 33] * q}, (f32x4){s[12 * 33] * q, s[13 * 33] * q, s[14 * 33] * q, s[15 * 33] * q});
            *(u32x4*)((unsigned char*)t.dst + (size_t)n * t.ldw + 16 * c4) = (u32x4){lo.x, lo.y, hi.x, hi.y}; }
    } else {
        const int c = lane & 7;
#pragma unroll
        for (int j = 0; j < 4; ++j) { const int n = (lane >> 3) + 8 * j; const LAS float* s = scr + (8 * c) * 33 + n;
            u32x4 o; o.x = cvt_pk_bf16(s[0 * 33], s[1 * 33]); o.y = cvt_pk_bf16(s[2 * 33], s[3 * 33]); o.z = cvt_pk_bf16(s[4 * 33], s[5 * 33]); o.w = cvt_pk_bf16(s[6 * 33], s[7 * 33]);
            *(u32x4*)(t.dst + (size_t)n * t.ldw + 8 * c) = o; } }
    LDS_WAIT(); asm volatile("" ::: "memory");
}
template <class Dec>
__device__ __forceinline__ void convert_loop(Frame& F, int NIT, const Dec& dec) {
    LAS float* scr = (LAS float*)(F.lds + F.wave * 8704);
    const int NGW = F.G * NWAVES; int it = F.bid * NWAVES + F.wave;
    if (it >= NIT) return;
    TItem cur = dec(it); float a[32]; titem_load(cur, a, F.lane);
    for (;;) {
        const int nit = it + NGW; const bool has = nit < NIT; TItem nx = cur; float b[32];
        if (has) { nx = dec(nit); titem_load(nx, b, F.lane); }
        titem_store(cur, a, scr, F.lane);
        if (!has) break;
#pragma unroll
        for (int i = 0; i < 32; ++i) a[i] = b[i];
        cur = nx; it = nit;
    }
}
__device__ __forceinline__ int inproj_dest_row(int n0) {
    if (n0 >= C_QC && n0 < C_KC) { const int ub = C_QC + ((n0 - C_QC) >> 8) * 256, r = n0 - ub, hh = r >> 6, half = (r >> 5) & 1; return ub + half * 128 + 32 * hh; }
    if (n0 >= C_KC && n0 < C_VC) { const int r = n0 - C_KC, hh = r >> 6, half = (r >> 5) & 1; return C_KC + half * 128 + 32 * hh; }
    if (n0 >= C_VC && n0 < C_G)  { const int r = n0 - C_VC, hd = r >> 6, j = (r >> 5) & 1; return C_KC + 64 + 128 * hd + 32 * j; }
    return n0;
}
struct MixerDec { const float *win, *wba, *wbb, *wbc, *wout, *wglu; bf16_t *WinT, *WbrT, *WoutT, *WgluT; int in8;
    static constexpr int I_IN = 16 * 200, I_BA = 4 * 32, I_BC = 8 * 32, I_O = 16 * 32, I_GL = 4 * 8, NIT = I_IN + 2 * I_BA + I_BC + I_O + I_GL;
    __device__ __forceinline__ TItem operator()(int it) const { int r = it;
        if (r < I_IN) { const int k0 = 64 * (r / 200), n0 = 32 * (r % 200); return in8 ? TItem{win + (size_t)k0 * NIN + n0, (bf16_t*)((unsigned char*)WinT + (size_t)inproj_dest_row(n0) * DM + k0), NIN, DM, 64.0f}
                                                                                                 : TItem{win + (size_t)k0 * NIN + n0, WinT + (size_t)inproj_dest_row(n0) * DM + k0, NIN, DM, 0.f}; } r -= I_IN;
        if (r < I_BA) { const int k0 = 64 * (r / 32), n0 = 32 * (r % 32); return TItem{wba + (size_t)k0 * DM + n0, WbrT + (size_t)n0 * DM + k0, DM, DM, 0.f}; } r -= I_BA;
        if (r < I_BA) { const int k0 = 64 * (r / 32), n0 = 32 * (r % 32); return TItem{wbb + (size_t)k0 * DM + n0, WbrT + (size_t)n0 * DM + 256 + k0, DM, DM, 0.f}; } r -= I_BA;
        if (r < I_BC) { const int k0 = 64 * (r / 32), n0 = 32 * (r % 32); return TItem{wbc + (size_t)k0 * DM + n0, WbrT + (size_t)n0 * DM + 512 + k0, DM, DM, 0.f}; } r -= I_BC;
        if (r < I_O)  { const int k0 = 64 * (r / 32), n0 = 32 * (r % 32); return TItem{wout + (size_t)k0 * DM + n0, WoutT + (size_t)n0 * DM + k0, DM, DM, 0.f}; } r -= I_O;
        { const int k0 = 64 * (r / 8), n0 = 32 * (r % 8); return TItem{wglu + (size_t)k0 * 256 + n0, WgluT + (size_t)n0 * 256 + k0, 256, 256, 0.f}; } } };
__device__ __forceinline__ void convert_mixer_weights(Frame& F, int l) {
    MixerDec d{inptr(F, I_W_IN) + (size_t)l * DM * NIN, inptr(F, I_WBA) + (size_t)l * 256 * DM, inptr(F, I_WBB) + (size_t)l * 256 * DM, inptr(F, I_WBC) + (size_t)l * 512 * DM,
               inptr(F, I_WOUT) + (size_t)l * DM * DM, inptr(F, I_WGLU) + (size_t)l * 256 * 256,
               (bf16_t*)(F.ws + WS_WIN), (bf16_t*)(F.ws + WS_WBR), (bf16_t*)(F.ws + WS_WOUT), (bf16_t*)(F.ws + WS_WGLU), (IN8_MASK >> l) & 1};
    convert_loop(F, MixerDec::NIT, d);
}
struct FfnDec { const float *Wg, *Wu, *Wd; unsigned char *WguT, *WdT; int es; float sg, sd;
    static constexpr int I_G = 16 * 112, I_D = 56 * 32, I_E = 2 * I_G + I_D;
    __device__ __forceinline__ TItem operator()(int it) const { const int e = it / I_E; int r = it % I_E;
        if (r < I_G) { const int k0 = 64 * (r / 112), n0 = 32 * (r % 112); return TItem{Wg + (size_t)e * DM * DFF + (size_t)k0 * DFF + n0, (bf16_t*)(WguT + ((size_t)(e * 2 * DFF + (n0 >> 7) * 256 + (n0 & 127)) * DM + k0) * es), DFF, es == 1 ? DM : DM, es == 1 ? sg : 0.f}; } r -= I_G;
        if (r < I_G) { const int k0 = 64 * (r / 112), n0 = 32 * (r % 112); return TItem{Wu + (size_t)e * DM * DFF + (size_t)k0 * DFF + n0, (bf16_t*)(WguT + ((size_t)(e * 2 * DFF + (n0 >> 7) * 256 + 128 + (n0 & 127)) * DM + k0) * es), DFF, DM, es == 1 ? sg : 0.f}; } r -= I_G;
        { const int k0 = 64 * (r / 32), n0 = 32 * (r % 32); return TItem{Wd + (size_t)e * DFF * DM + (size_t)k0 * DM + n0, (bf16_t*)(WdT + ((size_t)(e * DM + n0) * DFF + k0) * es), DM, DFF, es == 1 ? sd : 0.f}; } } };
__device__ __forceinline__ void convert_ffn_weights(Frame& F, int l) {
    const bool moe = (l & 1); const int li = l >> 1, ne = moe ? NEXP : 1; const bool f8 = (FP8_MASK >> l) & 1;
    FfnDec d{moe ? inptr(F, I_MG) + (size_t)li * NEXP * DM * DFF : inptr(F, I_FG) + (size_t)li * DM * DFF,
             moe ? inptr(F, I_MU) + (size_t)li * NEXP * DM * DFF : inptr(F, I_FU) + (size_t)li * DM * DFF,
             moe ? inptr(F, I_MD) + (size_t)li * NEXP * DFF * DM : inptr(F, I_FD) + (size_t)li * DFF * DM,
             F.ws + WS_WGU, F.ws + WS_WD, f8 ? 1 : 2, 64.0f, 128.0f};
    convert_loop(F, ne * FfnDec::I_E, d);
}
__device__ __forceinline__ void rope_table(Frame& F) {
    float* rc = (float*)(F.ws + WS_ROPE); float* rs = rc + SEQ * 32;
    for (int idx = F.bid * NTHREADS + F.tid; idx < SEQ * 32; idx += F.G * NTHREADS) { const int t = idx >> 5, i = idx & 31;
        const float inv = exp2f(-(float)i * (17.194602975157967f / 32.0f));
        double rev = (double)t * (double)inv * 0.15915494309189535; rev -= floor(rev); const float rf = (float)rev;
        rc[idx] = __builtin_amdgcn_cosf(rf); rs[idx] = __builtin_amdgcn_sinf(rf); }
}
__device__ __forceinline__ void s5_prep(Frame& F, int l, int gg, int sub) {
    LAS float* apow = (LAS float*)F.lds;
    LAS float* Bb = apow + 33 * 64 * 2;
    LAS float* Cc = Bb + 64 * 16 * 2;
    LAS float* Kt = Cc + 16 * 64 * 2;
    const float* lam_re = inptr(F, I_LAM_RE) + (size_t)(l * 16 + gg) * 64; const float* lam_im = inptr(F, I_LAM_IM) + (size_t)(l * 16 + gg) * 64;
    const float dt = __expf(inptr(F, I_LOG_DT)[l * 16 + gg]);
    const float* bre = inptr(F, I_B_RE) + (size_t)(l * 16 + gg) * 64 * 16; const float* bim = inptr(F, I_B_IM) + (size_t)(l * 16 + gg) * 64 * 16;
    const float* cre = inptr(F, I_C_RE) + (size_t)(l * 16 + gg) * 16 * 64; const float* cim = inptr(F, I_C_IM) + (size_t)(l * 16 + gg) * 16 * 64;
    __syncthreads();
    for (int idx = F.tid; idx < 33 * 64; idx += NTHREADS) { const int k = idx >> 6, n = idx & 63; const float lr = lam_re[n], li = lam_im[n];
        const float mag = __expf(lr * dt * (float)k); double rev = (double)li * (double)dt * (double)k * 0.15915494309189535; rev -= floor(rev); const float rf = (float)rev;
        apow[idx * 2] = mag * __builtin_amdgcn_cosf(rf); apow[idx * 2 + 1] = mag * __builtin_amdgcn_sinf(rf); }
    for (int idx = F.tid; idx < 16 * 64; idx += NTHREADS) { Cc[idx * 2] = cre[idx]; Cc[idx * 2 + 1] = cim[idx]; }
    __syncthreads();
    for (int idx = F.tid; idx < 64 * 16; idx += NTHREADS) { const int n = idx >> 4; const float lr = lam_re[n], li = lam_im[n];
        const float are = apow[(64 + n) * 2], aim = apow[(64 + n) * 2 + 1], nr = are - 1.0f, ni = aim, den = lr * lr + li * li;
        const float zre = (nr * lr + ni * li) / den, zim = (ni * lr - nr * li) / den, br = bre[idx], bi = bim[idx];
        Bb[idx * 2] = zre * br - zim * bi; Bb[idx * 2 + 1] = zre * bi + zim * br; }
    __syncthreads();
    for (int idx = F.tid; idx < 32 * 32; idx += NTHREADS) { const int k = idx >> 5, pl = (idx >> 4) & 1, q = idx & 15, p = 2 * sub + pl; float s = 0.f;
        for (int n = 0; n < 64; ++n) { const float ar = apow[(k * 64 + n) * 2], ai = apow[(k * 64 + n) * 2 + 1], br = Bb[(n * 16 + q) * 2], bi = Bb[(n * 16 + q) * 2 + 1];
            const float tr = ar * br - ai * bi, ti = ar * bi + ai * br; s += Cc[(p * 64 + n) * 2] * tr - Cc[(p * 64 + n) * 2 + 1] * ti; }
        Kt[idx] = s; }
    __syncthreads();
    bf16_t* Toep = (bf16_t*)(F.ws + WS_TOEP) + (size_t)gg * 512 * S5K;
    for (int ci = F.tid; ci < 64 * 80; ci += NTHREADS) { const int rl = ci / 80, cc = ci % 80, t = rl >> 1, pl = rl & 1, p = 2 * sub + pl, row = t * 16 + p; float v[8];
        if (cc < 64) { const int sx = cc >> 1, q0 = (cc & 1) * 8;
#pragma unroll
            for (int j = 0; j < 8; ++j) v[j] = (t >= sx) ? Kt[(t - sx) * 32 + pl * 16 + q0 + j] : 0.f;
        } else { const int c2 = cc - 64, im = c2 >> 3, n0 = (c2 & 7) * 8;
#pragma unroll
            for (int j = 0; j < 8; ++j) { const int n = n0 + j; const float ar = apow[((t + 1) * 64 + n) * 2], ai = apow[((t + 1) * 64 + n) * 2 + 1], cr = Cc[(p * 64 + n) * 2], cim2 = Cc[(p * 64 + n) * 2 + 1];
                v[j] = im ? -(cr * ai + cim2 * ar) : (cr * ar - cim2 * ai); } }
        u32x4 o; o.x = cvt_pk_bf16(v[0], v[1]); o.y = cvt_pk_bf16(v[2], v[3]); o.z = cvt_pk_bf16(v[4], v[5]); o.w = cvt_pk_bf16(v[6], v[7]);
        *(u32x4*)(Toep + (size_t)row * S5K + cc * 8) = o; }
    bf16_t* Em = (bf16_t*)(F.ws + WS_E) + (size_t)gg * 256 * 512;
    for (int ci = F.tid; ci < 32 * 64; ci += NTHREADS) { const int row = 32 * sub + (ci >> 6), cc = ci & 63, sx = cc >> 1, q0 = (cc & 1) * 8; float v[8];
        if (row < 128) { const int im = row >> 6, n = row & 63; const float ar = apow[((31 - sx) * 64 + n) * 2], ai = apow[((31 - sx) * 64 + n) * 2 + 1];
#pragma unroll
            for (int j = 0; j < 8; ++j) { const float br = Bb[(n * 16 + q0 + j) * 2], bi = Bb[(n * 16 + q0 + j) * 2 + 1]; v[j] = im ? (ar * bi + ai * br) : (ar * br - ai * bi); }
        } else {
#pragma unroll
            for (int j = 0; j < 8; ++j) v[j] = 0.f; }
        u32x4 o; o.x = cvt_pk_bf16(v[0], v[1]); o.y = cvt_pk_bf16(v[2], v[3]); o.z = cvt_pk_bf16(v[4], v[5]); o.w = cvt_pk_bf16(v[6], v[7]);
        *(u32x4*)(Em + (size_t)row * 512 + cc * 8) = o; }
    if (sub == 0 && F.tid < 64) { float* aT = (float*)(F.ws + WS_AT) + gg * 128; aT[F.tid * 2] = apow[(32 * 64 + F.tid) * 2]; aT[F.tid * 2 + 1] = apow[(32 * 64 + F.tid) * 2 + 1]; }
    __syncthreads();
}

__device__ __forceinline__ void load_moe_off(Frame& F, int ls) {
    __syncthreads();
    if (F.tid < 8) { int zz = 0; asm volatile("" : "+v"(zz));
        F.moff[16 + F.tid] = (ls & 1) ? (int)__hip_atomic_load(F.ctl + CW_MOECNT + 16 * (ls >> 1) + F.tid, __ATOMIC_RELAXED, __HIP_MEMORY_SCOPE_AGENT) : ((F.tid == 0) ? MTOK + zz : zz); }
    __syncthreads();
    if (F.tid == 0) {
        int o = 0, fp = 0, np = 0; int zz = 0; asm volatile("" : "+v"(zz));
#pragma unroll 1
        for (int e = zz; e < 8; ++e) {
            const int c = F.moff[16 + e];
            F.moff[e] = o; F.moff[24 + e] = fp; o += (c + 255) & ~255; fp += c >> 8;
            if (c & 255) { F.moff[40 + np] = e; F.moff[48 + e] = np; ++np; } else F.moff[48 + e] = zz - 1; }
        F.moff[8] = o; F.moff[32] = fp; F.moff[33] = np;
    }
    __syncthreads();
}

constexpr int NORM_R = 4;
__device__ __forceinline__ void norm_phase(Frame& F, const void* xin_, int xbf, bf16_t* xout, const bf16_t* yb, int add_mode, const float* gain, bf16_t* hout, float* fout,
                                           const float* router, unsigned* gcnt, int* blkcnt = nullptr, int dry_in = 0, int h8 = 0) {
    int dry = dry_in; asm volatile("" : "+s"(dry));
    const int gw = F.bid * NWAVES + F.wave, NGW = F.G * NWAVES;
    const int* toke = (const int*)(F.ws + WS_TOKE); const int* tokp = (const int*)(F.ws + WS_TOKP); const float* tokw = (const float*)(F.ws + WS_TOKW);
    LAS float* rT = (LAS float*)F.lds;
    LAS int* lcnt = (LAS int*)(F.lds + 32768);
    LAS int* rec = (LAS int*)(F.lds + 32768 + 1024);
    if (router) {
        for (int idx = F.tid; idx < DM * NEXP; idx += NTHREADS) rT[(idx & 7) * DM + (idx >> 3)] = router[idx];
        if (F.tid < 64) lcnt[F.tid] = 0;
        __syncthreads();
    }
    f32x4 gn[4];
#pragma unroll
    for (int j = 0; j < 4; ++j) gn[j] = *(const f32x4*)(gain + 4 * F.lane + 256 * j);
    int iter = 0;
    constexpr int R = NORM_R;
    float eps_l = RMS_EPS; asm volatile("" : "+v"(eps_l));
    for (int m0 = gw * R; m0 < MTOK; m0 += NGW * R) {
        f32x4 v[R][4];
        if (xbf) {
#pragma unroll
            for (int rr = 0; rr < R; ++rr) { const u32x2* xr = (const u32x2*)((const bf16_t*)xin_ + (size_t)(m0 + rr) * DM) + F.lane;
#pragma unroll
                for (int j = 0; j < 4; ++j) { const u32x2 w = __builtin_nontemporal_load(xr + 64 * j); v[rr][j] = (f32x4){bf_lo(w.x), bf_hi(w.x), bf_lo(w.y), bf_hi(w.y)}; } }
        } else {
#pragma unroll
        for (int rr = 0; rr < R; ++rr) { const f32x4* xr = (const f32x4*)((const float*)xin_ + (size_t)(m0 + rr) * DM) + F.lane;
#pragma unroll
            for (int j = 0; j < 4; ++j) v[rr][j] = __builtin_nontemporal_load(xr + 64 * j); } }
        if (add_mode == 1) {
            u32x2 w[R][4];
#pragma unroll
            for (int rr = 0; rr < R; ++rr) { const u32x2* yr = (const u32x2*)(yb + (size_t)(m0 + rr) * DM) + F.lane;
#pragma unroll
                for (int j = 0; j < 4; ++j) w[rr][j] = __builtin_nontemporal_load(yr + 64 * j); }
#pragma unroll
            for (int rr = 0; rr < R; ++rr)
#pragma unroll
                for (int j = 0; j < 4; ++j) v[rr][j] += (f32x4){bf_lo(w[rr][j].x), bf_hi(w[rr][j].x), bf_lo(w[rr][j].y), bf_hi(w[rr][j].y)};
        } else if (add_mode == 2) {
            u32x2 wa[R][4], wb[R][4]; float w0[R], w1[R];
#pragma unroll
            for (int rr = 0; rr < R; ++rr) { const int m = m0 + rr; const int e0 = toke[2 * m], e1 = toke[2 * m + 1]; w0[rr] = tokw[2 * m]; w1[rr] = tokw[2 * m + 1];
                const int d0 = F.moff[e0] + tokp[2 * m], d1 = F.moff[e1] + tokp[2 * m + 1];
                const u32x2* y0 = (const u32x2*)(yb + (size_t)d0 * DM) + F.lane; const u32x2* y1 = (const u32x2*)(yb + (size_t)d1 * DM) + F.lane;
#pragma unroll
                for (int j = 0; j < 4; ++j) { wa[rr][j] = __builtin_nontemporal_load(y0 + 64 * j); wb[rr][j] = __builtin_nontemporal_load(y1 + 64 * j); }
            }
#pragma unroll
            for (int rr = 0; rr < R; ++rr)
#pragma unroll
                for (int j = 0; j < 4; ++j) { const u32x2 a = wa[rr][j], b = wb[rr][j];
                    v[rr][j] += (f32x4){bf_lo(a.x), bf_hi(a.x), bf_lo(a.y), bf_hi(a.y)} * w0[rr] + (f32x4){bf_lo(b.x), bf_hi(b.x), bf_lo(b.y), bf_hi(b.y)} * w1[rr]; }
        }
        if (add_mode && !dry && xout) {
#pragma unroll
            for (int rr = 0; rr < R; ++rr) { u32x2* xo = (u32x2*)(xout + (size_t)(m0 + rr) * DM) + F.lane;
#pragma unroll
                for (int j = 0; j < 4; ++j) { u32x2 w; w.x = cvt_pk_bf16(v[rr][j].x, v[rr][j].y); w.y = cvt_pk_bf16(v[rr][j].z, v[rr][j].w); __builtin_nontemporal_store(w, xo + 64 * j); } } }
        float ss[R];
#pragma unroll
        for (int rr = 0; rr < R; ++rr) { ss[rr] = 0.f;
#pragma unroll
            for (int j = 0; j < 4; ++j) ss[rr] += (v[rr][j].x * v[rr][j].x + v[rr][j].y * v[rr][j].y) + (v[rr][j].z * v[rr][j].z + v[rr][j].w * v[rr][j].w); }
#pragma unroll
        for (int o = 1; o < 64; o <<= 1) {
#pragma unroll
            for (int rr = 0; rr < R; ++rr) ss[rr] += shfl_xor_l(ss[rr], o, F.lane); }
#pragma unroll
        for (int rr = 0; rr < R; ++rr) { const float rs = rsqrtf(ss[rr] * (1.0f / DM) + eps_l);
#pragma unroll
            for (int j = 0; j < 4; ++j) v[rr][j] = v[rr][j] * rs * gn[j]; }
        if (dry) { float z = 0.f;
#pragma unroll
            for (int rr = 0; rr < R; ++rr)
#pragma unroll
                for (int j = 0; j < 4; ++j) z += v[rr][j].x + v[rr][j].y + v[rr][j].z + v[rr][j].w;
            if (z == 1.2345e-30f) ((float*)(F.ws + WS_LSE))[0] = z; }
        else if (fout) {
#pragma unroll
            for (int rr = 0; rr < R; ++rr) { f32x4* fo = (f32x4*)(fout + (size_t)(m0 + rr) * DM) + F.lane;
#pragma unroll
                for (int j = 0; j < 4; ++j) __builtin_nontemporal_store(v[rr][j], fo + 64 * j); } }
        else if (h8) {
#pragma unroll
            for (int rr = 0; rr < R; ++rr) { unsigned* ho = (unsigned*)((unsigned char*)hout + (size_t)(m0 + rr) * DM) + F.lane;
#pragma unroll
                for (int j = 0; j < 4; ++j) { const u32x2 w = pack8_fp8(v[rr][j] * 8.0f, (f32x4){0.f, 0.f, 0.f, 0.f}); ho[64 * j] = w.x; } } }
        else {
#pragma unroll
            for (int rr = 0; rr < R; ++rr) { u32x2* ho = (u32x2*)(hout + (size_t)(m0 + rr) * DM) + F.lane;
#pragma unroll
                for (int j = 0; j < 4; ++j) { u32x2 w; w.x = cvt_pk_bf16(v[rr][j].x, v[rr][j].y); w.y = cvt_pk_bf16(v[rr][j].z, v[rr][j].w); ho[64 * j] = w; } } }
        if (router && !dry) {
#pragma unroll
            for (int rr = 0; rr < R; ++rr, ++iter) { const int m = m0 + rr;
                float lg[8];
#pragma unroll
                for (int e = 0; e < 8; ++e) { float s = 0.f;
#pragma unroll
                    for (int j = 0; j < 4; ++j) { const f32x4 r = *(const LAS f32x4*)(rT + e * DM + 4 * F.lane + 256 * j); s += (v[rr][j].x * r.x + v[rr][j].y * r.y) + (v[rr][j].z * r.z + v[rr][j].w * r.w); }
                    lg[e] = s; }
#pragma unroll
                for (int o = 1; o < 64; o <<= 1) {
#pragma unroll
                    for (int e = 0; e < 8; ++e) lg[e] += shfl_xor_l(lg[e], o, F.lane); }
                int e0 = 0; float v0 = lg[0];
#pragma unroll
                for (int e = 1; e < 8; ++e) if (lg[e] > v0) { v0 = lg[e]; e0 = e; }
                int e1 = -1; float v1 = -INFINITY;
#pragma unroll
                for (int e = 0; e < 8; ++e) if (e != e0 && lg[e] > v1) { v1 = lg[e]; e1 = e; }
                if (F.lane == 0) { const float w0 = 1.0f / (1.0f + __expf(v1 - v0));
                    float* tw = (float*)(F.ws + WS_TOKW); tw[2 * m] = w0; tw[2 * m + 1] = 1.0f - w0;
                    LAS int* wc_ = lcnt + F.wave * 8; const int r0 = wc_[e0]; wc_[e0] = r0 + 1; const int r1 = wc_[e1]; wc_[e1] = r1 + 1;
                    LAS int* rc = rec + (F.wave * 64 + (iter & 63)) * 4; rc[0] = m; rc[1] = e0 | (e1 << 8); rc[2] = r0; rc[3] = r1; }
            }
        }
    }
    if (router && !dry) {
        LAS int* niter = lcnt + 128;
        if (F.lane == 0) niter[F.wave] = iter;
        __syncthreads();
        if (F.tid < 64) { const int w = F.tid >> 3, e = F.tid & 7; int b = 0; for (int w2 = 0; w2 < w; ++w2) b += lcnt[w2 * 8 + e]; lcnt[64 + F.tid] = b; }
        if (F.tid < 8) { int t = 0; for (int w2 = 0; w2 < 8; ++w2) t += lcnt[w2 * 8 + F.tid];
            blkcnt[F.bid * 8 + F.tid] = t; __hip_atomic_fetch_add(gcnt + F.tid, (unsigned)t, __ATOMIC_RELAXED, __HIP_MEMORY_SCOPE_AGENT); }
        __syncthreads();
        int* te = (int*)(F.ws + WS_TOKE); int* tp = (int*)(F.ws + WS_TOKP);
        { const int w = F.tid >> 6, i = F.tid & 63; if (i < niter[w]) { const LAS int* rc = rec + (w * 64 + i) * 4; const int m = rc[0], e0 = rc[1] & 255, e1 = rc[1] >> 8;
            te[2 * m] = e0; te[2 * m + 1] = e1; tp[2 * m] = lcnt[64 + w * 8 + e0] + rc[2]; tp[2 * m + 1] = lcnt[64 + w * 8 + e1] + rc[3]; } }
        __syncthreads();
    }
}

__device__ __forceinline__ void moe_finalize(Frame& F, const int* blkcnt) {
    LAS int* bb = (LAS int*)(F.lds + 32768);
    __syncthreads();
    { const int e = F.tid & 7, part = F.tid >> 3; int s0 = 0;
#pragma unroll
        for (int k = 0; k < 16; ++k) { const int j = part + 64 * k; if (j < F.bid) s0 += blkcnt[j * 8 + e]; }
        bb[64 + F.tid] = s0; }
    __syncthreads();
    if (F.tid < 8) { int s1 = 0; for (int p = 0; p < 64; ++p) s1 += bb[64 + p * 8 + F.tid]; bb[F.tid] = s1; }
    __syncthreads();
    const int* te = (const int*)(F.ws + WS_TOKE); int* tp = (int*)(F.ws + WS_TOKP); int* trw = (int*)(F.ws + WS_TOKROW);
    const int NGW = F.G * NWAVES;
    for (int idx = F.tid; idx < NWAVES * 64; idx += NTHREADS) { const int w = idx >> 6, i = idx & 63, it = i / NORM_R, rr = i % NORM_R;
        const long m0 = (long)(F.bid * NWAVES + w) * NORM_R + (long)it * NGW * NORM_R; if (m0 >= MTOK) continue; const int m = (int)m0 + rr;
        const int e0 = te[2 * m], e1 = te[2 * m + 1], p0 = bb[e0] + tp[2 * m], p1 = bb[e1] + tp[2 * m + 1];
        tp[2 * m] = p0; tp[2 * m + 1] = p1; trw[(size_t)e0 * MTOK + p0] = m; trw[(size_t)e1 * MTOK + p1] = m; }
}

__device__ __forceinline__ void moe_gather(Frame& F) {
    const int gw = F.bid * NWAVES + F.wave, NGW = F.G * NWAVES;
    const int* toke = (const int*)(F.ws + WS_TOKE); const int* tokp = (const int*)(F.ws + WS_TOKP);
    const bf16_t* h = (const bf16_t*)(F.ws + WS_H); bf16_t* hs = (bf16_t*)(F.ws + WS_Y);
    for (int m = gw; m < MTOK; m += NGW) {
        const u32x4* src = (const u32x4*)(h + (size_t)m * DM) + F.lane; const u32x4 a = src[0], b = src[64];
        const int d0 = F.moff[toke[2 * m]] + tokp[2 * m], d1 = F.moff[toke[2 * m + 1]] + tokp[2 * m + 1];
        u32x4* o0 = (u32x4*)(hs + (size_t)d0 * DM) + F.lane; u32x4* o1 = (u32x4*)(hs + (size_t)d1 * DM) + F.lane;
        o0[0] = a; o0[64] = b; o1[0] = a; o1[64] = b;
    }
}

__device__ __forceinline__ int crow(int r, int hi) { return (r & 3) + 8 * (r >> 2) + 4 * hi; }
__device__ __forceinline__ s16x4 vtr(const LAS unsigned char* p) { return __builtin_bit_cast(s16x4, __builtin_amdgcn_ds_read_tr16_b64_v4i16((LAS v4i16_t*)p)); }
__device__ __forceinline__ void attn_phase(Frame& F, int l, int dry_in = 0) {
    int dry = dry_in; asm volatile("" : "+s"(dry));
    int tid_ = F.tid; asm volatile("" : "+v"(tid_));
    const int hw = F.wave >> 2, sw = F.wave & 3, t256 = tid_ & 255, lane = tid_ & 63, r = lane & 31, h = lane >> 5;
    LAS unsigned char* Kimg = F.lds + hw * 65536; LAS unsigned char* Vimg = Kimg + 32768;
    bf16_t* P = (bf16_t*)(F.ws + WS_PROJ); bf16_t* ocat = (bf16_t*)(F.ws + WS_OCAT); float* lse = (float*)(F.ws + WS_LSE);
    const float LOG2E = 1.4426950408889634f;
    const int rx = (r >> 1) & 7;
    int kofs[4];
#pragma unroll
    for (int ds = 0; ds < 4; ++ds) kofs[ds] = (32 * sw + r) * 128 + (((2 * ds + h) ^ rx) * 16);
    const int gi = lane >> 4, i16 = lane & 15, q = i16 >> 2, p = i16 & 3, xq = (q >> 1) & 1;
    const int vbase = (32 * sw + 4 * h + q) * 128 + ((2 * (gi & 1) + (p >> 1)) * 16) + (p & 1) * 8;
    int vofs[2];
#pragma unroll
    for (int db = 0; db < 2; ++db) vofs[db] = vbase + ((db ^ xq) * 64);
    for (int u = F.bid; u < 2560; u += F.G) {
        const int ub = u & 255, set = (u >> 8) * 8 + (ub & 7), w = (ub >> 3) * 2 + hw;
        int dl, nbk, qcol, kcol, vcol, hd, grp, blk; float sink = -INFINITY; bool isC;
        if (set >= 32) { const int gi = (set - 32) * 4 + (w >> 4); grp = gi >> 6; hd = (gi >> 4) & 3; blk = (gi & 15) * 16 + (w & 15); dl = (grp == 0) ? 1 : (grp == 1 ? 4 : 16); nbk = 16 / dl;
            qcol = C_QA + grp * 256 + hd * 64; kcol = C_KA + grp * 256 + hd * 64; vcol = C_VA + grp * 256 + hd * 64; isC = false; }
        else { grp = 3; hd = (set >> 4) * 4 + (w & 3); blk = (set & 15) * 16 + (w >> 2); dl = 1; nbk = 16; qcol = C_QC + hd * 64; kcol = C_KC + (hd >> 2) * 64; vcol = C_VC + (hd >> 2) * 64; isC = true;
            sink = inptr(F, I_SINKS)[l * 8 + hd]; }
        const int b = blk >> 4, within = blk & 15, ph = within / nbk, nb = within % nbk, tok0 = b * SEQ + ph;
        __syncthreads();
        u32x4 kreg[8], vreg[8];
#pragma unroll
        for (int it = 0; it < 8; ++it) { const int ci = it * 256 + t256, kl = ci >> 3, ch = ci & 7;
            if (nb > 0 || kl >= 128) { const size_t tok = (size_t)tok0 + (size_t)(nb * 128 - 128 + kl) * dl; const bf16_t* rp = P + tok * NIN + ch * 8;
                kreg[it] = *(const u32x4*)(rp + kcol); vreg[it] = *(const u32x4*)(rp + vcol); }
            else { kreg[it] = (u32x4){0u, 0u, 0u, 0u}; vreg[it] = (u32x4){0u, 0u, 0u, 0u}; } }
        const size_t qtok = (size_t)tok0 + (size_t)(nb * 128 + sw * 32 + r) * dl;
        bf16x8 qf[4];
#pragma unroll
        for (int ds = 0; ds < 4; ++ds) qf[ds] = *(const bf16x8*)(P + qtok * NIN + qcol + 16 * ds + 8 * h);
#pragma unroll
        for (int it = 0; it < 8; ++it) { const int ci = it * 256 + t256, kl = ci >> 3, ch = ci & 7;
            *(LAS u32x4*)(Kimg + kl * 128 + ((ch ^ ((kl >> 1) & 7)) * 16)) = kreg[it];
            *(LAS u32x4*)(Vimg + kl * 128 + ((ch ^ ((kl & 2) << 1)) * 16)) = vreg[it]; }
        __syncthreads();
        f32x16 sb[5];
#pragma unroll
        for (int kb = 0; kb < 5; ++kb) {
            const bool valid = (nb > 0) || (sw + kb >= 4);
            f32x16 x;
#pragma unroll
            for (int i = 0; i < 16; ++i) x[i] = 0.f;
            if (valid) {
#pragma unroll
                for (int ds = 0; ds < 4; ++ds) { const bf16x8 kf = *(const LAS bf16x8*)(Kimg + kofs[ds] + kb * 4096); x = __builtin_amdgcn_mfma_f32_32x32x16_bf16(kf, qf[ds], x, 0, 0, 0); }
                if (kb == 0) {
#pragma unroll
                    for (int i = 0; i < 16; ++i) if (crow(i, h) < r) x[i] = -INFINITY; }
                if (kb == 4) {
#pragma unroll
                    for (int i = 0; i < 16; ++i) if (crow(i, h) > r) x[i] = -INFINITY; }
            } else {
#pragma unroll
                for (int i = 0; i < 16; ++i) x[i] = -INFINITY; }
            sb[kb] = x;
        }
        float mx = sink;
#pragma unroll
        for (int kb = 0; kb < 5; ++kb)
#pragma unroll
            for (int i = 0; i < 16; ++i) mx = fmaxf(mx, sb[kb][i]);
        mx = fmaxf(mx, shfl_xor_l(mx, 32, lane));
        float lsum = 0.f; const float nmx = -mx * LOG2E;
#pragma unroll
        for (int kb = 0; kb < 5; ++kb)
#pragma unroll
            for (int i = 0; i < 16; ++i) { const float pv = __builtin_amdgcn_exp2f(__builtin_fmaf(sb[kb][i], LOG2E, nmx)); sb[kb][i] = pv; lsum += pv; }
        lsum += shfl_xor_l(lsum, 32, lane);
        if (isC) lsum += __builtin_amdgcn_exp2f((sink - mx) * LOG2E);
        f32x16 o[2];
#pragma unroll
        for (int db = 0; db < 2; ++db)
#pragma unroll
            for (int i = 0; i < 16; ++i) o[db][i] = 0.f;
#pragma unroll
        for (int kb = 0; kb < 5; ++kb) {
            const bool valid = (nb > 0) || (sw + kb >= 4);
            if (valid) {
#pragma unroll
                for (int s = 0; s < 2; ++s) {
                    u32x4 pw; pw.x = cvt_pk_bf16(sb[kb][8 * s + 0], sb[kb][8 * s + 1]); pw.y = cvt_pk_bf16(sb[kb][8 * s + 2], sb[kb][8 * s + 3]);
                    pw.z = cvt_pk_bf16(sb[kb][8 * s + 4], sb[kb][8 * s + 5]); pw.w = cvt_pk_bf16(sb[kb][8 * s + 6], sb[kb][8 * s + 7]);
                    const bf16x8 pb = __builtin_bit_cast(bf16x8, pw);
#pragma unroll
                    for (int db = 0; db < 2; ++db) {
                        const s16x4 lo = vtr(Vimg + vofs[db] + kb * 4096 + s * 2048), hi = vtr(Vimg + vofs[db] + kb * 4096 + s * 2048 + 1024);
                        const bf16x8 va = (bf16x8){lo[0], lo[1], lo[2], lo[3], hi[0], hi[1], hi[2], hi[3]};
                        o[db] = __builtin_amdgcn_mfma_f32_32x32x16_bf16(va, pb, o[db], 0, 0, 0);
                    }
                }
            }
        }
        const float inv = 1.0f / lsum;
        if (dry) continue;
        bf16_t* op = isC ? (ocat + qtok * DM + 512 + hd * 64) : (P + qtok * NIN + qcol);
#pragma unroll
        for (int db = 0; db < 2; ++db)
#pragma unroll
            for (int ig = 0; ig < 4; ++ig) { u32x2 w; w.x = cvt_pk_bf16(o[db][4 * ig] * inv, o[db][4 * ig + 1] * inv); w.y = cvt_pk_bf16(o[db][4 * ig + 2] * inv, o[db][4 * ig + 3] * inv);
                *(u32x2*)(op + 32 * db + 8 * ig + 4 * h) = w; }
        if (!isC && h == 0) lse[((size_t)grp * MTOK + qtok) * 4 + hd] = mx + __logf(lsum);
    }
    __syncthreads();
}

__device__ __forceinline__ void scan_combine_phase(Frame& F) {
    bf16_t* U2 = (bf16_t*)(F.ws + WS_U2); const float* Sst = (const float*)(F.ws + WS_SST); const float* aTt = (const float*)(F.ws + WS_AT);
    if (F.wave == 0) {
        for (int pr = F.bid; pr < 256; pr += F.G) { const int b = pr >> 4, gg = pr & 15, n = F.lane;
            const float ar = aTt[gg * 128 + 2 * n], ai = aTt[gg * 128 + 2 * n + 1];
            float hr = 0.f, hi = 0.f;
            const size_t row0 = (size_t)gg * S5ROWS + b * S5NC;
#pragma unroll 1
            for (int c0 = 0; c0 < S5NC; c0 += 16) { float sr[16], si[16];
#pragma unroll
                for (int j = 0; j < 16; ++j) { sr[j] = Sst[(row0 + c0 + j) * 128 + n]; si[j] = Sst[(row0 + c0 + j) * 128 + 64 + n]; }
#pragma unroll
                for (int j = 0; j < 16; ++j) { bf16_t* up = U2 + (row0 + c0 + j) * S5K + 512 + n;
                    up[0] = (bf16_t)(cvt_pk_bf16(hr, 0.f) & 0xffffu); up[64] = (bf16_t)(cvt_pk_bf16(hi, 0.f) & 0xffffu);
                    const float nr = ar * hr - ai * hi + sr[j], ni = ar * hi + ai * hr + si[j]; hr = nr; hi = ni; } }
        }
    }
    const bf16_t* P = (const bf16_t*)(F.ws + WS_PROJ); bf16_t* ocat = (bf16_t*)(F.ws + WS_OCAT); const float* lse = (const float*)(F.ws + WS_LSE);
    for (size_t it = (size_t)F.bid * NTHREADS + F.tid; it < (size_t)MTOK * 32; it += (size_t)F.G * NTHREADS) { const size_t tok = it >> 5; const int c8 = (int)(it & 31), hd = c8 >> 3;
        const float l0 = lse[(0 * (size_t)MTOK + tok) * 4 + hd], l1 = lse[(1 * (size_t)MTOK + tok) * 4 + hd], l2 = lse[(2 * (size_t)MTOK + tok) * 4 + hd];
        const float mm = fmaxf(l0, fmaxf(l1, l2)); float w0 = __expf(l0 - mm), w1 = __expf(l1 - mm), w2 = __expf(l2 - mm); const float iv = __builtin_amdgcn_rcpf(w0 + w1 + w2); w0 *= iv; w1 *= iv; w2 *= iv;
        const bf16_t* pp = P + tok * NIN + C_QA + c8 * 8;
        f32x4 a0, a1, b0, b1, c0, c1; unpack8(*(const u32x4*)(pp), a0, a1); unpack8(*(const u32x4*)(pp + 256), b0, b1); unpack8(*(const u32x4*)(pp + 512), c0, c1);
        *(u32x4*)(ocat + tok * DM + c8 * 8) = pack8(a0 * w0 + b0 * w1 + c0 * w2, a1 * w0 + b1 * w1 + c1 * w2); }
}

__device__ __forceinline__ void splitk_reduce(Frame& F) {
    const int np = F.moff[33]; const int gw = F.bid * NWAVES + F.wave, NGW = F.G * NWAVES;
    bf16_t* y = (bf16_t*)(F.ws + WS_Y); const bf16_t* part = (const bf16_t*)(F.ws + WS_YPART);
    for (int it = gw; it < np * 256; it += NGW) { const int pi = it >> 8, r = it & 255, e = F.moff[40 + pi], c = F.moff[16 + e];
        if (r >= (c & 255)) continue;
        u32x2* yr = (u32x2*)(y + (size_t)(F.moff[e] + (c & ~255) + r) * DM) + F.lane;
        u32x2 w[7][4];
#pragma unroll
        for (int j = 0; j < 4; ++j) w[0][j] = yr[64 * j];
#pragma unroll
        for (int ks = 0; ks < 6; ++ks) { const u32x2* pr = (const u32x2*)(part + ((size_t)ks * 2048 + pi * 256 + r) * DM) + F.lane;
#pragma unroll
            for (int j = 0; j < 4; ++j) w[ks + 1][j] = pr[64 * j]; }
#pragma unroll
        for (int j = 0; j < 4; ++j) { f32x4 a = (f32x4){0.f, 0.f, 0.f, 0.f};
#pragma unroll
            for (int ks = 0; ks < 7; ++ks) a += (f32x4){bf_lo(w[ks][j].x), bf_hi(w[ks][j].x), bf_lo(w[ks][j].y), bf_hi(w[ks][j].y)};
            u32x2 o; o.x = cvt_pk_bf16(a[0], a[1]); o.y = cvt_pk_bf16(a[2], a[3]); yr[64 * j] = o; }
    }
}

__global__ void __launch_bounds__(NTHREADS, 2) trunk_fwd(Args args) {
    extern __shared__ __attribute__((aligned(16))) unsigned char lds_raw[];
    Frame F;
    F.lds = (LAS unsigned char*)lds_raw;
    F.MISC = (volatile LAS unsigned*)(F.lds + LDSCTL_OFF + 320);
    F.moff = (LAS int*)(F.lds + LDSCTL_OFF + 512);
    F.tid = threadIdx.x; F.lane = F.tid & 63; F.wave = __builtin_amdgcn_readfirstlane(F.tid >> 6);
    F.G = gridDim.x; F.bid = blockIdx.x; F.ws = args.ws; F.ctl = (unsigned*)(args.ws + WS_CTL);
    for (int u = F.tid; u < (LDS_BYTES - LDSCTL_OFF) / 4; u += NTHREADS) ((LAS unsigned*)(F.lds + LDSCTL_OFF))[u] = 0u;
    __syncthreads();
    if (F.tid == 0) { LAS unsigned long long* tab = (LAS unsigned long long*)(F.lds + LDSCTL_OFF + 1024);
#pragma unroll
        for (int i = 0; i < 27; ++i) tab[i] = (unsigned long long)args.in[i]; }
    __syncthreads();
    const int lo = args.ph_lo, hi = args.ph_hi; const int wave0 = F.wave, bid0 = F.bid, grid0 = F.G; unsigned char* const ws0 = F.ws;
    XcdBarrier bar; bar.bar = F.ctl + CW_BAR; bar.x = 0; bar.st = nullptr;
    if (hi - lo > 1) bar = xcd_barrier_post(F.ctl + CW_BAR, F.MISC + 8);
#define IN(k) (lo <= (k) && (k) < hi)
#define REFRESH() do { int l_; asm volatile("v_mbcnt_lo_u32_b32 %0, -1, 0\n\tv_mbcnt_hi_u32_b32 %0, -1, %0" : "=v"(l_)); F.lane = l_; int w_ = wave0, b_ = bid0, g_ = grid0; unsigned long long p_ = (unsigned long long)ws0; asm volatile("" : "+s"(w_), "+s"(b_), "+s"(g_), "+s"(p_)); F.wave = w_; F.bid = b_; F.G = g_; F.ws = (unsigned char*)(GAS unsigned char*)p_; F.ctl = (unsigned*)(GAS unsigned*)p_; F.tid = w_ * 64 + l_; } while (0)
#define SEAM(k) do { if ((k) + 1 < hi) { REFRESH(); xcd_barrier(bar, F.tid == 0); if (PRB(11)) { REFRESH(); xcd_barrier(bar, F.tid == 0); REFRESH(); xcd_barrier(bar, F.tid == 0); } } } while (0)
#define Hb ((bf16_t*)(F.ws + WS_H))
#define Xb ((bf16_t*)(F.ws + WS_XB))
#define Pb ((bf16_t*)(F.ws + WS_PROJ))
#define Ocat ((bf16_t*)(F.ws + WS_OCAT))
#define Merged ((bf16_t*)(F.ws + WS_MERGED))
#define U2 ((bf16_t*)(F.ws + WS_U2))
#define Sst ((float*)(F.ws + WS_SST))
#define Gact ((bf16_t*)(F.ws + WS_GACT))
#define Hid ((bf16_t*)(F.ws + WS_HID))
#define Yb ((bf16_t*)(F.ws + WS_Y))
#define ropec ((const float*)(F.ws + WS_ROPE))
#define ropes ((const float*)(F.ws + WS_ROPE) + SEQ * 32)

#pragma unroll 1
    for (int l = 0; l < DEPTH; ++l) {
        const int pb = PPL * l; const bool moe = (l & 1);
        if (PHM(0) && IN(pb + 0)) { REFRESH();
            if (l == 0) rope_table(F);
            for (int rep = 0; rep < 1 + PRB(0); ++rep) {
            for (int wi = F.bid; wi < 128; wi += F.G) s5_prep(F, l, wi >> 3, wi & 7);
            convert_mixer_weights(F, l); }
            __syncthreads();
            if (l == 0) { norm_phase(F, inptr(F, I_X), 0, nullptr, nullptr, 0, inptr(F, I_NORM_MIX), Hb, nullptr, nullptr, nullptr, nullptr, 0, IN8_MASK & 1); if (PRB(2)) norm_phase(F, inptr(F, I_X), 0, nullptr, nullptr, 0, inptr(F, I_NORM_MIX), Hb, nullptr, nullptr, nullptr, nullptr, 1); }
            else { load_moe_off(F, l - 1); norm_phase(F, Xb, 1, Xb, Yb, ((l - 1) & 1) ? 2 : 1, inptr(F, I_NORM_MIX) + l * DM, Hb, nullptr, nullptr, nullptr, nullptr, 0, (IN8_MASK >> l) & 1);
                if (PRB(2)) norm_phase(F, Xb, 1, Xb, Yb, ((l - 1) & 1) ? 2 : 1, inptr(F, I_NORM_MIX) + l * DM, Hb, nullptr, nullptr, nullptr, nullptr, 1); }
            SEAM(pb + 0);
        }
        if (PHM(1) && IN(pb + 1)) { REFRESH();
            if ((IN8_MASK >> l) & 1) { REFRESH();
                pg8::Gemm g{Hb, (const bf16_t*)(F.ws + WS_WIN), DM / 2, DM / 2, DM / 2}; pg8::GridOrder S{MTOK / 256, NIN / 256, F.G, F.bid};
                pg8::EpiInProjT<true> E{Pb, U2, ropec, ropes, F.ws + WS_G8};
                pg8::gemm_phase(F.lds, F.tid, g, S, E);
            } else { REFRESH();
            pg8::Gemm g{Hb, (const bf16_t*)(F.ws + WS_WIN), DM, DM, DM}; pg8::GridOrder S{MTOK / 256, NIN / 256, F.G, F.bid};
            pg8::EpiInProj E{Pb, U2, ropec, ropes, F.ws + WS_G8};
            if (PRB(9)) { pg8::EpiBf16Plain E0{Pb, NIN, NIN / 256, nullptr}; pg8::gemm_phase(F.lds, F.tid, g, S, E0); REFRESH(); } pg8::gemm_phase(F.lds, F.tid, g, S, E); if (PRB(4)) { REFRESH(); pg8::gemm_phase(F.lds, F.tid, g, S, E); }
            }
            SEAM(pb + 1);
        }
        if (PHM(2) && IN(pb + 2)) { REFRESH();
            { pg8::Gemm g{U2, (const bf16_t*)(F.ws + WS_E), S5K, 512, 512}; pg8::S5StateOrder S{F.G, F.bid}; pg8::EpiS5State E{Sst}; pg8::gemm_phase(F.lds, F.tid, g, S, E); if (PRB(3)) { REFRESH(); pg8::gemm_phase(F.lds, F.tid, g, S, E); } }
            attn_phase(F, l);
            if (PRB(1)) attn_phase(F, l, 1);
            SEAM(pb + 2);
        }
        if (PHM(3) && IN(pb + 3)) { REFRESH(); scan_combine_phase(F); if (PRB(3)) scan_combine_phase(F); SEAM(pb + 3); }
        if (PHM(4) && IN(pb + 4)) { REFRESH();
            pg8::Gemm g{U2, (const bf16_t*)(F.ws + WS_TOEP), S5K, S5K, S5K}; pg8::S5MainOrder S{F.G, F.bid}; pg8::EpiS5Main E{U2, inptr(F, I_S5D) + l * 256, Gact};
            pg8::gemm_phase(F.lds, F.tid, g, S, E); if (PRB(3)) { REFRESH(); pg8::gemm_phase(F.lds, F.tid, g, S, E); }
            SEAM(pb + 4);
        }
        if (PHM(5) && IN(pb + 5)) { REFRESH();
            pg8::Gemm g{Gact, (const bf16_t*)(F.ws + WS_WGLU), 256, 256, 256}; pg8::GridOrderT<true> S{MTOK / 128, 1, F.G, F.bid}; pg8::EpiGLU E{Gact, inptr(F, I_BGLU) + l * 256, Ocat};
            pg8::gemm_phase(F.lds, F.tid, g, S, E); if (PRB(3)) { REFRESH(); pg8::gemm_phase(F.lds, F.tid, g, S, E); }
            SEAM(pb + 5);
        }
        if (PHM(6) && IN(pb + 6)) { REFRESH();
            pg8::Gemm g{Ocat, (const bf16_t*)(F.ws + WS_WBR), DM, DM, DM}; pg8::GridOrder S{MTOK / 256, DM / 256, F.G, F.bid}; pg8::EpiBranch E{F.ws + WS_G8, Merged};
            pg8::gemm_phase(F.lds, F.tid, g, S, E); if (PRB(5)) { REFRESH(); pg8::gemm_phase(F.lds, F.tid, g, S, E); }
            SEAM(pb + 6);
        }
        if (PHM(7) && IN(pb + 7)) { REFRESH();
            pg8::Gemm g{Merged, (const bf16_t*)(F.ws + WS_WOUT), DM, DM, DM}; pg8::GridOrder S{MTOK / 256, DM / 256, F.G, F.bid}; pg8::EpiBf16Plain E{Hb, DM, DM / 256, nullptr};
            pg8::gemm_phase(F.lds, F.tid, g, S, E); if (PRB(8)) { REFRESH(); pg8::gemm_phase(F.lds, F.tid, g, S, E); }
            SEAM(pb + 7);
        }
        if (PHM(8) && IN(pb + 8)) { REFRESH();
            for (int rep = 0; rep < 1 + PRB(0); ++rep) convert_ffn_weights(F, l);
            __syncthreads();
            norm_phase(F, l == 0 ? (const void*)inptr(F, I_X) : (const void*)Xb, l == 0 ? 0 : 1, Xb, Hb, 1, inptr(F, I_NORM_FFN) + l * DM, ((FP8_MASK >> l) & 1) ? Merged : Hb, nullptr,
                       moe ? inptr(F, I_ROUTER) + (size_t)(l >> 1) * DM * NEXP : nullptr, F.ctl + CW_MOECNT + 16 * (l >> 1), (int*)(F.ws + WS_BLKCNT) + (l >> 1) * 8192, 0, (FP8_MASK >> l) & 1);
            if (PRB(2)) norm_phase(F, Xb, 1, Xb, Hb, 1, inptr(F, I_NORM_FFN) + l * DM, Hb, nullptr, nullptr, nullptr, nullptr, 1);
            SEAM(pb + 8);
        }
        if (PHM(9) && IN(pb + 9) && moe) { REFRESH(); moe_finalize(F, (const int*)(F.ws + WS_BLKCNT) + (l >> 1) * 8192); SEAM(pb + 9); }
        if (PHM(10) && IN(pb + 10)) { REFRESH();
            load_moe_off(F, l);
            const int nT = F.moff[8] >> 8;
            if ((FP8_MASK >> l) & 1) { REFRESH();
#if FP8_FULL
                pg8::Gemm g{Merged, (const bf16_t*)(F.ws + WS_WGU), DM / 2, DM / 2, DM / 2}; pg8::FfnOrderT<true, false> S{nT, 2 * DFF / 256, F.G, F.bid, F.moff, (const int*)(F.ws + WS_TOKROW), moe ? 0 : 1};
                pg8::EpiSwiGLU8F E{F.ws + WS_HID, 2 * DFF / 256};
#else
                pg8::Gemm g{Merged, (const bf16_t*)(F.ws + WS_WGU), DM / 2, DM / 2, DM / 2}; pg8::FfnOrderT<true, true> S{2 * nT, 2 * DFF / 256, F.G, F.bid, F.moff, (const int*)(F.ws + WS_TOKROW), moe ? 0 : 1};
                pg8::EpiSwiGLU8 E{F.ws + WS_HID, 2 * DFF / 256};
#endif
                pg8::gemm_phase(F.lds, F.tid, g, S, E);
            } else { REFRESH();
            pg8::Gemm g{Hb, (const bf16_t*)(F.ws + WS_WGU), DM, DM, DM}; pg8::FfnOrderT<true> S{nT, 2 * DFF / 256, F.G, F.bid, F.moff, (const int*)(F.ws + WS_TOKROW), moe ? 0 : 1}; pg8::EpiSwiGLU E{Hid, 2 * DFF / 256};
            pg8::gemm_phase(F.lds, F.tid, g, S, E); if (PRB(6)) { REFRESH(); pg8::gemm_phase(F.lds, F.tid, g, S, E); }
            }
            SEAM(pb + 10);
        }
        if (PHM(11) && IN(pb + 11)) { REFRESH();
            load_moe_off(F, l);
            const int nT = F.moff[8] >> 8;
            if ((FP8_MASK >> l) & 1) { REFRESH();
#if FP8_FULL
                pg8::Gemm g{Hid, (const bf16_t*)(F.ws + WS_WD), DFF / 2, DFF / 2, DFF / 2}; pg8::FfnDownOrder S{F.G, F.bid, F.moff, pg8::DOWN_KSUB, DFF / 128};
                pg8::EpiBf16Plain8F E{Yb, DM, DM / 256, (bf16_t*)(F.ws + WS_YPART)};
#else
                pg8::Gemm g{Hid, (const bf16_t*)(F.ws + WS_WD), DFF / 2, DFF / 2, DFF / 2}; pg8::FfnDownOrderH S{F.G, F.bid, F.moff, pg8::DOWN_KSUB, DFF / 128};
                pg8::EpiBf16Plain8 E{Yb, DM, DM / 256, (bf16_t*)(F.ws + WS_YPART)};
#endif
                pg8::gemm_phase(F.lds, F.tid, g, S, E);
            } else { REFRESH();
            pg8::Gemm g{Hid, (const bf16_t*)(F.ws + WS_WD), DFF, DFF, DFF}; pg8::FfnDownOrder S{F.G, F.bid, F.moff, pg8::DOWN_KSUB * 2, DFF / 64}; pg8::EpiBf16Plain E{Yb, DM, DM / 256, (bf16_t*)(F.ws + WS_YPART)};
            pg8::gemm_phase(F.lds, F.tid, g, S, E); if (PRB(7)) { REFRESH(); pg8::gemm_phase(F.lds, F.tid, g, S, E); }
            }
            SEAM(pb + 11);
        }
        if (PHM(11) && IN(pb + 12) && moe) { REFRESH(); load_moe_off(F, l); splitk_reduce(F); SEAM(pb + 12); }
    }
    if (PHM(12) && IN(PPL * DEPTH)) { REFRESH(); load_moe_off(F, DEPTH - 1); norm_phase(F, Xb, 1, nullptr, Yb, ((DEPTH - 1) & 1) ? 2 : 1, inptr(F, I_NORM_FINAL), nullptr, args.out, nullptr, nullptr);
        if (PRB(2)) norm_phase(F, Xb, 1, nullptr, Yb, ((DEPTH - 1) & 1) ? 2 : 1, inptr(F, I_NORM_FINAL), nullptr, args.out, nullptr, nullptr, nullptr, 1); }
#undef IN
#undef SEAM
}

extern "C" void kernel_launch(void* const* d_in, const int* in_sizes, int n_in, void* d_out, int out_size, void* d_ws, size_t ws_size, hipStream_t stream) {
    static int grid = 0;
    if (grid == 0) {
        if (n_in != 27 || in_sizes[0] != MTOK * DM || out_size != MTOK * DM || ws_size < WS_END) { fprintf(stderr, "kernel_launch: unexpected shapes (n_in %d, in0 %d, out %d, ws %zu < %zu); nothing launched\n", n_in, n_in > 0 ? in_sizes[0] : -1, out_size, ws_size, (size_t)WS_END); grid = -1; return; }
        int dev = 0, cus = 0, per_cu = 0;
        if (hipGetDevice(&dev) != hipSuccess || hipDeviceGetAttribute(&cus, hipDeviceAttributeMultiprocessorCount, dev) != hipSuccess) { grid = -1; return; }
        if (hipFuncSetAttribute((const void*)trunk_fwd, hipFuncAttributeMaxDynamicSharedMemorySize, LDS_BYTES) != hipSuccess) { fprintf(stderr, "kernel_launch: hipFuncSetAttribute failed\n"); grid = -1; return; }
        if (hipOccupancyMaxActiveBlocksPerMultiprocessor(&per_cu, (const void*)trunk_fwd, NTHREADS, LDS_BYTES) != hipSuccess || per_cu < 1) { fprintf(stderr, "kernel_launch: occupancy query reports %d blocks per CU\n", per_cu); }
        (void)hipGetLastError();
        grid = cus;
    }
    if (grid < 0) return;
    if (hipMemsetAsync((char*)d_ws + WS_CTL, 0, CTL_ZERO_BYTES, stream) != hipSuccess) return;
    Args a{};
    for (int i = 0; i < 27; ++i) a.in[i] = (const float*)d_in[i];
    a.out = (float*)d_out; a.ws = (unsigned char*)d_ws;
#if MK_ONE_LAUNCH
    a.ph_lo = 0; a.ph_hi = NPH;
    hipLaunchKernelGGL(trunk_fwd, dim3(grid), dim3(NTHREADS), LDS_BYTES, stream, a);
#else
    for (int p = 0; p < NPH; ++p) {
        if (p < PPL * DEPTH && ((p % PPL) == 9 || (p % PPL) == 12) && ((p / PPL) & 1) == 0) continue;
        a.ph_lo = p; a.ph_hi = p + 1;
        hipLaunchKernelGGL(trunk_fwd, dim3(grid), dim3(NTHREADS), LDS_BYTES, stream, a);
    }
#endif
}
```

```cpp
#include <hip/hip_runtime.h>
#include <cstdio>
#include <cstdint>

#ifndef PROBE_DOUBLE
#define PROBE_DOUBLE 0
#endif
#define PRB(k) (((PROBE_DOUBLE) >> (k)) & 1)
#ifndef FP8_MASK
#define FP8_MASK 0xE
#endif
#ifndef MK_ONE_LAUNCH
#define MK_ONE_LAUNCH 1
#endif

#ifndef IN8_MASK
#define IN8_MASK 0xF
#endif
#ifndef FP8_FULL
#define FP8_FULL 1
#endif
#ifndef PH_MASK
#define PH_MASK 0x1FFF
#endif
#define PHM(k) (((PH_MASK) >> (k)) & 1)
#define LAS __attribute__((address_space(3)))
#define GAS __attribute__((address_space(1)))
typedef unsigned short bf16_t;
typedef short bf16x8 __attribute__((ext_vector_type(8)));
typedef short s16x4 __attribute__((ext_vector_type(4)));
typedef short v4i16_t __attribute__((ext_vector_type(4)));
typedef float f32x2 __attribute__((ext_vector_type(2)));
typedef float f32x4 __attribute__((ext_vector_type(4)));
typedef float f32x16 __attribute__((ext_vector_type(16)));
typedef unsigned u32x2 __attribute__((ext_vector_type(2)));
typedef unsigned u32x4 __attribute__((ext_vector_type(4)));
typedef __bf16 bf16x2_t __attribute__((ext_vector_type(2)));
typedef int v4i32 __attribute__((ext_vector_type(4)));
typedef int v8i32 __attribute__((ext_vector_type(8)));

constexpr int BATCH = 16, SEQ = 2048, DM = 1024, MTOK = BATCH * SEQ, DEPTH = 4;
constexpr int NIN = 6400, DFF = 3584, NEXP = 8;
constexpr int C_QA = 0, C_KA = 768, C_VA = 1536, C_U = 2304, C_QC = 2560, C_KC = 3072, C_VC = 3200, C_G = 3328;
constexpr int S5T = 32, S5NC = SEQ / S5T, S5ROWS = BATCH * S5NC, S5K = 640;
constexpr int MOE_ROWS = 67584;
constexpr float RMS_EPS = 1e-6f;
constexpr int NWAVES = 8, NTHREADS = 512;
constexpr int PPL = 13, NPH = PPL * DEPTH + 1;

constexpr size_t MiB = 1u << 20;
constexpr size_t WS_CTL = 0, CTL_ZERO_BYTES = 1 * MiB;
constexpr size_t WS_ROPE = 1 * MiB;
constexpr size_t WS_AT = 1 * MiB + 512 * 1024;
constexpr size_t WS_TOKE = 2 * MiB, WS_TOKP = 2 * MiB + 256 * 1024, WS_TOKW = 2 * MiB + 512 * 1024;
constexpr size_t WS_LSE = 3 * MiB;
constexpr size_t WS_TOKROW = 5 * MiB;
constexpr size_t WS_BLKCNT = 6 * MiB;
constexpr size_t WS_WIN = 8 * MiB, WS_WBR = 21 * MiB, WS_WOUT = 23 * MiB, WS_WGLU = 25 * MiB, WS_TOEP = 26 * MiB, WS_E = 36 * MiB, WS_WGU = 40 * MiB, WS_WD = 96 * MiB, WS_XB = 124 * MiB;
constexpr size_t WS_H = 208 * MiB;
constexpr size_t WS_PROJ = 272 * MiB, WS_OCAT = 672 * MiB, WS_MERGED = 736 * MiB, WS_U2 = 800 * MiB, WS_SST = 820 * MiB, WS_GACT = 828 * MiB;
constexpr size_t WS_HID = 272 * MiB, WS_Y = 734 * MiB, WS_YPART = 866 * MiB, WS_G8 = 890 * MiB, WS_END = 986 * MiB;
static_assert(WS_WIN + (size_t)NIN * DM * 2 <= WS_WBR && WS_TOEP + (size_t)16 * 512 * S5K * 2 <= WS_E && WS_E + (size_t)16 * 256 * 512 * 2 <= WS_WGU, "ws map 1");
static_assert((FP8_MASK & 0xA) == 0xA, "the ws map holds the MoE FFN weights as fp8 bytes");
static_assert(WS_WGU + (size_t)NEXP * 2 * DFF * DM <= WS_WD && WS_WGU + (size_t)2 * DFF * DM * 2 <= WS_WD && WS_WD + (size_t)NEXP * DM * DFF <= WS_XB && WS_WD + (size_t)DM * DFF * 2 <= WS_XB && WS_XB + (size_t)MTOK * DM * 2 <= WS_H && WS_H + (size_t)MTOK * DM * 2 <= WS_PROJ, "ws map 2");
static_assert(WS_PROJ + (size_t)MTOK * NIN * 2 <= WS_OCAT && WS_U2 + (size_t)16 * S5ROWS * S5K * 2 <= WS_SST && WS_SST + (size_t)16 * S5ROWS * 128 * 4 <= WS_GACT && WS_GACT + (size_t)MTOK * 256 * 2 <= WS_END, "ws map 3");
static_assert(WS_HID + (size_t)MOE_ROWS * DFF * 2 <= WS_Y && WS_Y + (size_t)MOE_ROWS * DM * 2 <= WS_YPART && WS_YPART + (size_t)6 * 2048 * DM * 2 <= WS_G8 && WS_G8 + (size_t)MTOK * 3 * DM <= WS_END, "ws map 4");
constexpr int CW_TMO = 0, CW_MOECNT = 64, CW_BAR = 4096;

constexpr int RING_BYTES = 131072;
constexpr int LDSCTL_OFF = RING_BYTES;
constexpr int LDS_BYTES = 147456;

__device__ __forceinline__ unsigned cvt_pk_bf16(float lo, float hi) { f32x2 v = {lo, hi}; bf16x2_t b = __builtin_convertvector(v, bf16x2_t); return __builtin_bit_cast(unsigned, b); }
__device__ __forceinline__ float bf_lo(unsigned w) { return __uint_as_float(w << 16); }
__device__ __forceinline__ float bf_hi(unsigned w) { return __uint_as_float(w & 0xffff0000u); }
__device__ __forceinline__ u32x4 pack8(const f32x4 a, const f32x4 b) { u32x4 w; w.x = cvt_pk_bf16(a[0], a[1]); w.y = cvt_pk_bf16(a[2], a[3]); w.z = cvt_pk_bf16(b[0], b[1]); w.w = cvt_pk_bf16(b[2], b[3]); return w; }
__device__ __forceinline__ void unpack8(const u32x4 w, f32x4& a, f32x4& b) { a = (f32x4){bf_lo(w.x), bf_hi(w.x), bf_lo(w.y), bf_hi(w.y)}; b = (f32x4){bf_lo(w.z), bf_hi(w.z), bf_lo(w.w), bf_hi(w.w)}; }
__device__ __forceinline__ unsigned pack4_gate(float a, float b, float c, float d) {
    const unsigned w0 = __builtin_bit_cast(unsigned, __builtin_amdgcn_cvt_pknorm_u16(a, b)), w1 = __builtin_bit_cast(unsigned, __builtin_amdgcn_cvt_pknorm_u16(c, d));
    return __builtin_amdgcn_perm(w1, w0, 0x07050301u) | 0x01010101u; }
__device__ __forceinline__ u32x2 pack8_gate(const f32x4 a, const f32x4 b) { u32x2 o; o.x = pack4_gate(a[0], a[1], a[2], a[3]); o.y = pack4_gate(b[0], b[1], b[2], b[3]); return o; }
__device__ __forceinline__ u32x2 pack8_u8(const f32x4 a, const f32x4 b) {
    unsigned q[8];
#pragma unroll
    for (int j = 0; j < 4; ++j) { q[j] = (unsigned)(a[j] + 0.5f); q[4 + j] = (unsigned)(b[j] + 0.5f); }
    u32x2 o; o.x = q[0] | (q[1] << 8) | (q[2] << 16) | (q[3] << 24); o.y = q[4] | (q[5] << 8) | (q[6] << 16) | (q[7] << 24); return o; }
__device__ __forceinline__ void unpack8_u8(const u32x2 w, f32x4& a, f32x4& b) {
    a = (f32x4){(float)(w.x & 255u), (float)((w.x >> 8) & 255u), (float)((w.x >> 16) & 255u), (float)(w.x >> 24)};
    b = (f32x4){(float)(w.y & 255u), (float)((w.y >> 8) & 255u), (float)((w.y >> 16) & 255u), (float)(w.y >> 24)}; }
__device__ __forceinline__ void unpack8_fp8(const u32x2 w, f32x4& a, f32x4& b) {
    const auto a0 = __builtin_amdgcn_cvt_pk_f32_fp8((int)w.x, false), a1 = __builtin_amdgcn_cvt_pk_f32_fp8((int)w.x, true), b0 = __builtin_amdgcn_cvt_pk_f32_fp8((int)w.y, false), b1 = __builtin_amdgcn_cvt_pk_f32_fp8((int)w.y, true);
    a = (f32x4){a0[0], a0[1], a1[0], a1[1]}; b = (f32x4){b0[0], b0[1], b1[0], b1[1]}; }
__device__ __forceinline__ void swap32(unsigned& a, unsigned& b) { const auto r = __builtin_amdgcn_permlane32_swap(a, b, false, false); a = r[0]; b = r[1]; }
__device__ __forceinline__ void swap16(unsigned& a, unsigned& b) { const auto r = __builtin_amdgcn_permlane16_swap(a, b, false, false); a = r[0]; b = r[1]; }
__device__ __forceinline__ u32x2 pack8_fp8(const f32x4 a, const f32x4 b) {
    f32x4 x = a, y = b;
#pragma unroll
    for (int j = 0; j < 4; ++j) { x[j] = __builtin_amdgcn_fmed3f(x[j], -448.0f, 448.0f); y[j] = __builtin_amdgcn_fmed3f(y[j], -448.0f, 448.0f); }
    int w0 = __builtin_amdgcn_cvt_pk_fp8_f32(x[0], x[1], 0, false); w0 = __builtin_amdgcn_cvt_pk_fp8_f32(x[2], x[3], w0, true);
    int w1 = __builtin_amdgcn_cvt_pk_fp8_f32(y[0], y[1], 0, false); w1 = __builtin_amdgcn_cvt_pk_fp8_f32(y[2], y[3], w1, true);
    u32x2 o; o.x = (unsigned)w0; o.y = (unsigned)w1; return o;
}
__device__ __forceinline__ float sigmoid_f(float x) { return __builtin_amdgcn_rcpf(1.0f + __expf(-x)); }
__device__ __forceinline__ float gelu_tanh_f(float x) { const float z = 0.7978845608f * (x + 0.044715f * x * x * x); const float t = 1.0f - 2.0f * __builtin_amdgcn_rcpf(1.0f + __expf(2.0f * z)); return 0.5f * x * (1.0f + t); }
__device__ __forceinline__ float shfl_xor_l(float v, int mask, int lane) { return __int_as_float(__builtin_amdgcn_ds_bpermute((lane ^ mask) << 2, __float_as_int(v))); }
#define LDS_WAIT() asm volatile("s_waitcnt lgkmcnt(0)" ::: "memory")

namespace pg8 {
#ifndef PG8_WGM
#define PG8_WGM 4
#endif
constexpr int BM = 256, BK = 64, HALF = 128, HTB = HALF * BK * 2, STAGE_BYTES = 8 * HTB, NXCD = 8, WGM = PG8_WGM;
__host__ __device__ __forceinline__ int lds_byte(int r, int c) { const int st = (r >> 4) * 2 + (c >> 5), rr = r & 15, cc = c & 31, ob = rr * 64 + cc * 2; return st * 1024 + (ob ^ (((ob >> 9) & 1) << 5)); }
__host__ __device__ __forceinline__ void stage_rc(int b, int& R, int& C) { const int st = b / 1024, sb = b % 1024, swz = sb ^ (((sb >> 9) & 1) << 5); R = (st >> 1) * 16 + swz / 64; C = (st & 1) * 32 + (swz % 64) / 2; }
__host__ __device__ __forceinline__ int perm32(int rho) { const int n = rho >> 4, i = rho & 15; return 8 * (i >> 2) + 4 * n + (i & 3); }

struct Unit { int pm, pn, koff = 0, nt = 0, ks = 0, pi = 0; };
struct Gemm { const bf16_t* A; const bf16_t* Bt; int lda, ldb, K; };

__device__ __forceinline__ void tile_order(int L, int nM, int nN, int& pm, int& pn) {
    const int nwg = nM * nN; int wgid = L; { const int q = nwg / NXCD, r = nwg % NXCD, xcd = wgid % NXCD, off = wgid / NXCD; wgid = (xcd < r ? xcd * (q + 1) : r * (q + 1) + (xcd - r) * q) + off; }
    const int nig = WGM * nN, gid = wgid / nig, fm = gid * WGM, gsz = (nM - fm) < WGM ? (nM - fm) : WGM;
    pm = fm + ((wgid % nig) % gsz); pn = (wgid % nig) / gsz;
}
template <bool HM> struct GridOrderT { static constexpr bool GATHER = false, SPLITK = false, HALFM = HM; int nM, nN, G, c;
    __device__ __forceinline__ bool next(int i, Unit& u) const { const int L = i * G + c; if (L >= nM * nN) return false; tile_order(L, nM, nN, u.pm, u.pn); return true; } };
using GridOrder = GridOrderT<false>;
struct S5StateOrder { static constexpr bool GATHER = false, SPLITK = false, HALFM = true; int G, c;
    __device__ __forceinline__ bool next(int i, Unit& u) const { const int L = i * G + c; if (L >= 128) return false; u.pm = L; u.pn = L >> 3; return true; } };
struct S5MainOrder { static constexpr bool GATHER = false, SPLITK = false, HALFM = true; int G, c;
    __device__ __forceinline__ bool next(int i, Unit& u) const { const int L = i * G + c; if (L >= 256) return false; const int g = L >> 4, r = L & 15; u.pm = g * 8 + (r & 7); u.pn = g * 2 + (r >> 3); return true; } };
template <bool GATHER_, bool HALFM_ = false> struct FfnOrderT { static constexpr bool GATHER = GATHER_, SPLITK = false, HALFM = HALFM_; static constexpr int RT = HALFM_ ? 128 : 256; int nT, nN, G, c; const LAS int* off; const int* tokrow; int dense;
    __device__ __forceinline__ bool next(int i, Unit& u) const { const int L = i * G + c; if (L >= nT * nN) return false; int pm, pnl; tile_order(L, nT, nN, pm, pnl);
        int e = 0;
#pragma unroll
        for (int k = 1; k < 8; ++k) e += (off[k] <= pm * RT) ? 1 : 0;
        u.pm = pm; u.pn = e * nN + pnl; return true; }
    __device__ __forceinline__ int tok(const Unit& u, int trow) const { const int sr = u.pm * RT + (trow & (RT - 1)); if (dense) return sr; const int e = u.pn / nN, pos = sr - off[e];
        return (pos < off[16 + e]) ? tokrow[(size_t)e * MTOK + pos] : 0; } };
constexpr int DOWN_SPL = 7, DOWN_KSUB = DFF / DOWN_SPL;
struct FfnDownOrder { static constexpr bool GATHER = false, SPLITK = true, HALFM = false; int G, c; const LAS int* mo; int slice_b, full_nt;
    __device__ __forceinline__ bool next(int i, Unit& u) const { const int L = i * G + c; const int nFull = mo[32], np = mo[33]; if (L >= nFull * 4 + np * 4 * DOWN_SPL) return false;
        if (L < nFull * 4) { int fi, pnl; tile_order(L, nFull, 4, fi, pnl); int e = 0;
#pragma unroll
            for (int k = 1; k < 8; ++k) e += (mo[24 + k] <= fi) ? 1 : 0;
            u.pm = (mo[e] >> 8) + (fi - mo[24 + e]); u.pn = e * 4 + pnl; u.koff = 0; u.nt = full_nt; u.ks = 0; u.pi = 0; }
        else { const int j = (int)(L - nFull * 4), ks = j % DOWN_SPL, rest = j / DOWN_SPL, pnl = rest & 3, pi = rest >> 2, e = mo[40 + pi];
            u.pm = (mo[e] >> 8) + (mo[16 + e] >> 8); u.pn = e * 4 + pnl; u.koff = ks * slice_b; u.nt = slice_b / (BK * 2); u.ks = ks; u.pi = pi; }
        return true; } };

struct FfnDownOrderH { static constexpr bool GATHER = false, SPLITK = true, HALFM = true; int G, c; const LAS int* mo; int slice_b, full_nt;
    __device__ __forceinline__ bool next(int i, Unit& u) const { const int L = i * G + c; const int nFullH = 2 * mo[32], npH = 2 * mo[33]; if (L >= nFullH * 4 + npH * 4 * DOWN_SPL) return false;
        if (L < nFullH * 4) { int fh, pnl; tile_order(L, nFullH, 4, fh, pnl); const int fi = fh >> 1; int e = 0;
#pragma unroll
            for (int k = 1; k < 8; ++k) e += (mo[24 + k] <= fi) ? 1 : 0;
            u.pm = ((mo[e] >> 8) + (fi - mo[24 + e])) * 2 + (fh & 1); u.pn = e * 4 + pnl; u.koff = 0; u.nt = full_nt; u.ks = 0; u.pi = 0; }
        else { const int j = (int)(L - nFullH * 4), ks = j % DOWN_SPL, rest = j / DOWN_SPL, pnl = rest & 3, ph = rest >> 2, e = mo[40 + (ph >> 1)];
            u.pm = ((mo[e] >> 8) + (mo[16 + e] >> 8)) * 2 + (ph & 1); u.pn = e * 4 + pnl; u.koff = ks * slice_b; u.nt = slice_b / (BK * 2); u.ks = ks; u.pi = ph; }
        return true; } };

template <class Epi, class Sched>
__device__ __forceinline__ void gemm_phase(LAS unsigned char* lds, const int tid, const Gemm g, const Sched& S, const Epi& E) {
    const int wid = __builtin_amdgcn_readfirstlane(tid >> 6), lane = tid & 63, wr = wid >> 2, wc = wid & 3, fr = lane & 15, fq = lane >> 4;
    const int K = g.K, nt = K / BK;
    unsigned voffA[2], voffB[2];
#pragma unroll
    for (int i = 0; i < 2; ++i) { int R, C; stage_rc(tid * 16 + i * 8192, R, C); const int Rb = Epi::PERM ? ((R & ~31) + perm32(R & 31)) : R;
        voffA[i] = (unsigned)(R * g.lda + C) * 2u; voffB[i] = (unsigned)(Rb * g.ldb + C) * 2u; }
    const size_t kstep = (size_t)(BK * 2);
    const size_t hstepA = (size_t)HALF * g.lda * 2, hstepB = (size_t)HALF * g.ldb * 2;
    static_assert(Epi::HALFM == Sched::HALFM, "half-tile epilogue and order go together");
    const size_t tstepA = Sched::GATHER ? 0 : (Sched::HALFM ? hstepA : 2 * hstepA), tstepB = 2 * hstepB;
    int gR[2], gC[2];
#pragma unroll
    for (int i = 0; i < 2; ++i) stage_rc(tid * 16 + i * 8192, gR[i], gC[i]);
    unsigned vA0[2], vA1[2], vN0[2], vN1[2];
#define PG8_GOFF(U, d0, d1) do { _Pragma("unroll") for (int _i = 0; _i < 2; ++_i) { \
        d0[_i] = (unsigned)((size_t)S.tok(U, gR[_i]) * g.lda + gC[_i]) * 2u; d1[_i] = (unsigned)((size_t)S.tok(U, HALF + gR[_i]) * g.lda + gC[_i]) * 2u; } } while (0)
#define PG8_STAGE_A(bufoff, base, half, v0, v1) do { if constexpr (Sched::GATHER) { if (half) PG8_STAGE(bufoff, base, v1); else PG8_STAGE(bufoff, base, v0); } \
        else { PG8_STAGE(bufoff, (base) + (half) * hstepA, voffA); } } while (0)
    const unsigned ldsw = (unsigned)wid * 1024u;
    const int aoff = lds_byte(wr * 64 + fr, fq * 8), boff = lds_byte(wc * 32 + fr, fq * 8);
#define PG8_SA(b, h) (((b) * 2 + (h)) * HTB)
#define PG8_SB(b, h) ((4 + (b) * 2 + (h)) * HTB)
#define PG8_STAGE(bufoff, gbase, voff) do { _Pragma("unroll") for (int _i = 0; _i < 2; ++_i) \
        __builtin_amdgcn_global_load_lds((const unsigned*)((const char*)(gbase) + (voff)[_i]), (LAS unsigned*)(lds + (bufoff) + ldsw + _i * 8192), 16, 0, 0); } while (0)
#define PG8_LDA(dst, b, h) do { _Pragma("unroll") for (int m = 0; m < 4; ++m) _Pragma("unroll") for (int k = 0; k < 2; ++k) dst[m][k] = *(const LAS bf16x8*)(lds + PG8_SA(b, h) + aoff + m * 2048 + k * 1024); } while (0)
#define PG8_LDB(dst, b, h) do { _Pragma("unroll") for (int n = 0; n < 2; ++n) _Pragma("unroll") for (int k = 0; k < 2; ++k) dst[n][k] = *(const LAS bf16x8*)(lds + PG8_SB(b, h) + boff + n * 2048 + k * 1024); } while (0)
#define PG8_MMA(ai, bj, At, Bt) do { __builtin_amdgcn_s_setprio(1); \
        if constexpr (Epi::FP8) { _Pragma("unroll") for (int m = 0; m < 4; ++m) _Pragma("unroll") for (int n = 0; n < 2; ++n) \
            asm volatile("v_mfma_scale_f32_16x16x128_f8f6f4 %0, %1, %2, %0, %3, %3 op_sel_hi:[0,0,0]" : "+v"(acc[ai][bj][m][n]) : "v"(__builtin_shufflevector(__builtin_bit_cast(v4i32, Bt[n][0]), __builtin_bit_cast(v4i32, Bt[n][1]), 0, 1, 2, 3, 4, 5, 6, 7)), \
                "v"(__builtin_shufflevector(__builtin_bit_cast(v4i32, At[m][0]), __builtin_bit_cast(v4i32, At[m][1]), 0, 1, 2, 3, 4, 5, 6, 7)), "v"(0x7f7f7f7f)); } \
        else { _Pragma("unroll") for (int m = 0; m < 4; ++m) _Pragma("unroll") for (int n = 0; n < 2; ++n) _Pragma("unroll") for (int k = 0; k < 2; ++k) \
            acc[ai][bj][m][n] = __builtin_amdgcn_mfma_f32_16x16x32_bf16(Bt[n][k], At[m][k], acc[ai][bj][m][n], 0, 0, 0); } \
        __builtin_amdgcn_s_setprio(0); } while (0)
#define PG8_WAIT_V(n) asm volatile("s_waitcnt vmcnt(" #n ")" ::: "memory")
#define PG8_WAIT_L(n) asm volatile("s_waitcnt lgkmcnt(" #n ")" ::: "memory")
#define PG8_BAR __builtin_amdgcn_s_barrier()
#define PG8_SCHED __builtin_amdgcn_sched_barrier(0)
    Unit cur, nxt; int ui = 0;
    if (!S.next(0, cur)) return;
    f32x4 acc[2][2][4][2];
#pragma unroll
    for (int a = 0; a < 2; ++a)
#pragma unroll
        for (int b = 0; b < 2; ++b)
#pragma unroll
            for (int m = 0; m < 4; ++m)
#pragma unroll
                for (int n = 0; n < 2; ++n) acc[a][b][m][n] = (f32x4){0.f, 0.f, 0.f, 0.f};
    bf16x8 At[4][2], B0[2][2], B1[2][2];
    const char* cA = (const char*)g.A + (size_t)cur.pm * tstepA; const char* cB = (const char*)g.Bt + (size_t)cur.pn * tstepB;
    if constexpr (Sched::SPLITK) { cA += cur.koff; cB += cur.koff; }
    if constexpr (Sched::GATHER) { PG8_GOFF(cur, vA0, vA1); }
    PG8_STAGE(PG8_SB(0, 0), cB, voffB); PG8_STAGE(PG8_SB(0, 1), cB + hstepB, voffB); PG8_STAGE_A(PG8_SA(0, 0), cA, 0, vA0, vA1); if constexpr (!Epi::HALFM) { PG8_STAGE_A(PG8_SA(0, 1), cA, 1, vA0, vA1); }
    if (wr == 1) PG8_BAR;
    if constexpr (Epi::HALFM) { PG8_WAIT_V(0); } else { PG8_WAIT_V(2); } PG8_BAR;
    PG8_STAGE(PG8_SB(1, 0), cB + kstep, voffB); PG8_STAGE_A(PG8_SA(1, 0), cA + kstep, 0, vA0, vA1); PG8_STAGE(PG8_SB(1, 1), cB + hstepB + kstep, voffB);
    PG8_WAIT_V(6); PG8_BAR;
    for (;;) {
        const bool has_next = S.next(ui + 1, nxt);
        const char* nA = has_next ? (const char*)g.A + (size_t)nxt.pm * tstepA : cA; const char* nB = has_next ? (const char*)g.Bt + (size_t)nxt.pn * tstepB : cB;
        if constexpr (Sched::SPLITK) { if (has_next) { nA += nxt.koff; nB += nxt.koff; } }
        const int unt = Sched::SPLITK ? cur.nt : nt;
        if constexpr (Sched::GATHER) { if (has_next) { PG8_GOFF(nxt, vN0, vN1); } else {
#pragma unroll
            for (int _i = 0; _i < 2; ++_i) { vN0[_i] = vA0[_i]; vN1[_i] = vA1[_i]; } } }
#pragma unroll 1
        for (int t = 0; t < unt; t += 2) {
            const bool last = (t == unt - 2);
            const char* a1 = cA + (size_t)(t + 1) * kstep;
            const char* a2 = last ? nA : cA + (size_t)(t + 2) * kstep; const char* b2 = last ? nB : cB + (size_t)(t + 2) * kstep;
            const char* a3 = a2 + kstep; const char* b3 = b2 + kstep;
            unsigned s0[2], s1[2];
            if constexpr (Sched::GATHER) {
#pragma unroll
                for (int _i = 0; _i < 2; ++_i) { s0[_i] = last ? vN0[_i] : vA0[_i]; s1[_i] = last ? vN1[_i] : vA1[_i]; } }
            PG8_LDB(B0, 0, 0); PG8_LDB(B1, 0, 1); PG8_SCHED; PG8_LDA(At, 0, 0); if constexpr (!Epi::HALFM) { PG8_STAGE_A(PG8_SA(1, 1), a1, 1, vA0, vA1); }
            PG8_WAIT_V(8); PG8_WAIT_L(0); PG8_BAR; PG8_MMA(0, 0, At, B0); if constexpr (!Epi::HALFM) { PG8_MMA(0, 1, At, B1); } PG8_BAR; PG8_SCHED;
            if constexpr (!Epi::HALFM) { PG8_LDA(At, 0, 1); } PG8_STAGE(PG8_SB(0, 0), b2, voffB); PG8_STAGE(PG8_SB(0, 1), b2 + hstepB, voffB); PG8_STAGE_A(PG8_SA(0, 0), a2, 0, s0, s1);
            if constexpr (Epi::HALFM) { PG8_WAIT_V(6); } else { PG8_WAIT_V(8); } PG8_WAIT_L(0); PG8_BAR; if constexpr (!Epi::HALFM) { PG8_MMA(1, 0, At, B0); PG8_MMA(1, 1, At, B1); } else { PG8_MMA(0, 1, At, B1); } PG8_BAR; PG8_SCHED;
            PG8_LDB(B0, 1, 0); PG8_LDB(B1, 1, 1); PG8_SCHED; PG8_LDA(At, 1, 0); if constexpr (!Epi::HALFM) { PG8_STAGE_A(PG8_SA(0, 1), a2, 1, s0, s1); }
            PG8_WAIT_V(8); PG8_WAIT_L(0); PG8_BAR; PG8_MMA(0, 0, At, B0); if constexpr (!Epi::HALFM) { PG8_MMA(0, 1, At, B1); } PG8_BAR; PG8_SCHED;
            if constexpr (!Epi::HALFM) { PG8_LDA(At, 1, 1); } PG8_STAGE(PG8_SB(1, 0), b3, voffB); PG8_STAGE(PG8_SB(1, 1), b3 + hstepB, voffB); PG8_STAGE_A(PG8_SA(1, 0), a3, 0, s0, s1);
            if constexpr (Epi::HALFM) { PG8_WAIT_V(6); } else { PG8_WAIT_V(8); } PG8_WAIT_L(0); PG8_BAR; if constexpr (!Epi::HALFM) { PG8_MMA(1, 0, At, B0); PG8_MMA(1, 1, At, B1); } else { PG8_MMA(0, 1, At, B1); } PG8_BAR; PG8_SCHED;
            if constexpr (Epi::HAS_MID) { if (t + 2 == Epi::MID1 || t + 2 == Epi::MID2) E.mid(acc, cur, wr, wc, fr, fq, (t + 2 == Epi::MID2) ? 1 : 0); }
        }
        if (wr == 0) PG8_BAR;
        E(acc, cur, wr, wc, fr, fq);
        if (!has_next) break;
#pragma unroll
        for (int a = 0; a < 2; ++a)
#pragma unroll
            for (int b = 0; b < 2; ++b)
#pragma unroll
                for (int m = 0; m < 4; ++m)
#pragma unroll
                    for (int n = 0; n < 2; ++n) acc[a][b][m][n] = (f32x4){0.f, 0.f, 0.f, 0.f};
        cur = nxt; cA = nA; cB = nB; ++ui;
        if constexpr (Sched::GATHER) {
#pragma unroll
            for (int _i = 0; _i < 2; ++_i) { vA0[_i] = vN0[_i]; vA1[_i] = vN1[_i]; } }
        if (wr == 1) PG8_BAR;
    }
    PG8_WAIT_V(0);
    PG8_BAR;
#undef PG8_GOFF
#undef PG8_STAGE_A
#undef PG8_SA
#undef PG8_SB
#undef PG8_STAGE
#undef PG8_LDA
#undef PG8_LDB
#undef PG8_MMA
#undef PG8_WAIT_V
#undef PG8_WAIT_L
#undef PG8_BAR
#undef PG8_SCHED
}

struct EpiBf16Plain {
    static constexpr bool PERM = true, HAS_MID = false, FP8 = false, HALFM = false; static constexpr int MID1 = -1, MID2 = -1;
    bf16_t* O; int ldc; int nNl; bf16_t* part;
    __device__ __forceinline__ void operator()(const f32x4 (&acc)[2][2][4][2], const Unit& u, int wr, int wc, int fr_in, int fq) const {
        int fr = fr_in; asm volatile("" : "+v"(fr));
        const int rt0 = wr * 64 + fr, col0 = (u.pn % nNl) * BM + wc * 32 + 8 * fq;
        bf16_t* base = (u.ks == 0) ? O + (size_t)(u.pm * BM + rt0) * ldc : part + (size_t)((u.ks - 1) * 2048 + u.pi * 256 + rt0) * ldc;
#pragma unroll
        for (int ai = 0; ai < 2; ++ai)
#pragma unroll
            for (int m = 0; m < 4; ++m) { bf16_t* rowp = base + (size_t)(ai * HALF + m * 16) * ldc + col0;
#pragma unroll
                for (int bj = 0; bj < 2; ++bj) *(u32x4*)(rowp + bj * HALF) = pack8(acc[ai][bj][m][0], acc[ai][bj][m][1]); }
    }
};
struct EpiSwiGLU {
    static constexpr bool PERM = true, HAS_MID = false, FP8 = false, HALFM = false; static constexpr int MID1 = -1, MID2 = -1;
    bf16_t* Hd; int nNl;
    __device__ __forceinline__ void operator()(const f32x4 (&acc)[2][2][4][2], const Unit& u, int wr, int wc, int fr_in, int fq) const {
        int fr = fr_in; asm volatile("" : "+v"(fr));
        const int row0 = u.pm * BM + wr * 64 + fr, col0 = (u.pn % nNl) * HALF + wc * 32 + 8 * fq;
#pragma unroll
        for (int ai = 0; ai < 2; ++ai)
#pragma unroll
            for (int m = 0; m < 4; ++m) { f32x4 o[2];
#pragma unroll
                for (int n = 0; n < 2; ++n)
#pragma unroll
                    for (int j = 0; j < 4; ++j) { const float gt = acc[ai][0][m][n][j], up = acc[ai][1][m][n][j]; o[n][j] = gt * sigmoid_f(gt) * up; }
                *(u32x4*)(Hd + (size_t)(row0 + ai * HALF + m * 16) * DFF + col0) = pack8(o[0], o[1]); }
    }
};
struct EpiSwiGLU8 {
    static constexpr bool PERM = true, HAS_MID = false, FP8 = true, HALFM = true; static constexpr int MID1 = -1, MID2 = -1;
    unsigned char* Hd; int nNl;
    __device__ __forceinline__ void operator()(const f32x4 (&acc)[2][2][4][2], const Unit& u, int wr, int wc, int fr_in, int fq) const {
        int fr = fr_in; asm volatile("" : "+v"(fr)); asm volatile("s_nop 15\n\ts_nop 15\n\ts_nop 15" ::: "memory");
        const int row0 = u.pm * HALF + wr * 64 + fr, col0 = (u.pn % nNl) * HALF + wc * 32 + 8 * fq;
#pragma unroll
        for (int m = 0; m < 4; ++m) { f32x4 o[2];
#pragma unroll
            for (int n = 0; n < 2; ++n)
#pragma unroll
                for (int j = 0; j < 4; ++j) { const float gt = acc[0][0][m][n][j] * 0.001953125f, up = acc[0][1][m][n][j] * 0.001953125f; o[n][j] = gt * sigmoid_f(gt) * up * 8.0f; }
            *(u32x2*)(Hd + (size_t)(row0 + m * 16) * DFF + col0) = pack8_fp8(o[0], o[1]); }
    }
};
struct EpiSwiGLU8F {
    static constexpr bool PERM = true, HAS_MID = false, FP8 = true, HALFM = false; static constexpr int MID1 = -1, MID2 = -1;
    unsigned char* Hd; int nNl;
    __device__ __forceinline__ void operator()(const f32x4 (&acc)[2][2][4][2], const Unit& u, int wr, int wc, int fr_in, int fq) const {
        int fr = fr_in; asm volatile("" : "+v"(fr)); asm volatile("s_nop 15\n\ts_nop 15\n\ts_nop 15" ::: "memory");
        const int row0 = u.pm * BM + wr * 64 + fr, col0 = (u.pn % nNl) * HALF + wc * 32 + 8 * fq;
#pragma unroll
        for (int ai = 0; ai < 2; ++ai)
#pragma unroll
        for (int mp = 0; mp < 2; ++mp) { u32x2 w[2];
#pragma unroll
          for (int mm = 0; mm < 2; ++mm) { const int m = 2 * mp + mm; f32x4 o[2];
#pragma unroll
            for (int n = 0; n < 2; ++n)
#pragma unroll
                for (int j = 0; j < 4; ++j) { const float ag = acc[ai][0][m][n][j], au = acc[ai][1][m][n][j];
                    const float t = __builtin_amdgcn_exp2f(ag * (-0.001953125f * 1.4426950408889634f)); o[n][j] = (ag * au) * __builtin_amdgcn_rcpf(__builtin_fmaf(t, 32768.0f, 32768.0f)); }
            w[mm] = pack8_fp8(o[0], o[1]); }
          unsigned a0 = w[0].x, a1 = w[0].y, b0 = w[1].x, b1 = w[1].y; swap16(a0, b0); swap16(a1, b1);
          *(u32x4*)(Hd + (size_t)(row0 + ai * HALF + (2 * mp + (fq & 1)) * 16) * DFF + (col0 - 8 * (fq & 1))) = (u32x4){a0, a1, b0, b1}; }
    }
};
struct EpiBf16Plain8F {
    static constexpr bool PERM = true, HAS_MID = false, FP8 = true, HALFM = false; static constexpr int MID1 = -1, MID2 = -1;
    bf16_t* O; int ldc; int nNl; bf16_t* part;
    __device__ __forceinline__ void operator()(const f32x4 (&acc)[2][2][4][2], const Unit& u, int wr, int wc, int fr_in, int fq) const {
        int fr = fr_in; asm volatile("" : "+v"(fr)); asm volatile("s_nop 15\n\ts_nop 15\n\ts_nop 15" ::: "memory");
        const int rt0 = wr * 64 + fr, col0 = (u.pn % nNl) * BM + wc * 32 + 8 * fq;
        bf16_t* base = (u.ks == 0) ? O + (size_t)(u.pm * BM + rt0) * ldc : part + (size_t)((u.ks - 1) * 2048 + u.pi * 256 + rt0) * ldc;
#pragma unroll
        for (int ai = 0; ai < 2; ++ai)
#pragma unroll
        for (int m = 0; m < 4; ++m) { bf16_t* rowp = base + (size_t)(ai * HALF + m * 16) * ldc + col0;
#pragma unroll
            for (int bj = 0; bj < 2; ++bj) *(u32x4*)(rowp + bj * HALF) = pack8(acc[ai][bj][m][0] * 0.0009765625f, acc[ai][bj][m][1] * 0.0009765625f); }
    }
};
struct EpiBf16Plain8 {
    static constexpr bool PERM = true, HAS_MID = false, FP8 = true, HALFM = true; static constexpr int MID1 = -1, MID2 = -1;
    bf16_t* O; int ldc; int nNl; bf16_t* part;
    __device__ __forceinline__ void operator()(const f32x4 (&acc)[2][2][4][2], const Unit& u, int wr, int wc, int fr_in, int fq) const {
        int fr = fr_in; asm volatile("" : "+v"(fr)); asm volatile("s_nop 15\n\ts_nop 15\n\ts_nop 15" ::: "memory");
        const int rt0 = wr * 64 + fr, col0 = (u.pn % nNl) * BM + wc * 32 + 8 * fq;
        bf16_t* base = (u.ks == 0) ? O + (size_t)(u.pm * HALF + rt0) * ldc : part + (size_t)((u.ks - 1) * 2048 + u.pi * HALF + rt0) * ldc;
#pragma unroll
        for (int m = 0; m < 4; ++m) { bf16_t* rowp = base + (size_t)(m * 16) * ldc + col0;
#pragma unroll
            for (int bj = 0; bj < 2; ++bj) *(u32x4*)(rowp + bj * HALF) = pack8(acc[0][bj][m][0] * 0.0009765625f, acc[0][bj][m][1] * 0.0009765625f); }
    }
};
template <bool F8> struct EpiInProjT {
    static constexpr bool PERM = true, HAS_MID = false, FP8 = F8, HALFM = false; static constexpr int MID1 = -1, MID2 = -1;
    static constexpr float A8 = F8 ? 0.001953125f : 1.0f;
    bf16_t* P; bf16_t* U2; const float* ropec; const float* ropes; unsigned char* G8;
    __device__ __forceinline__ void operator()(const f32x4 (&acc)[2][2][4][2], const Unit& u, int wr, int wc, int fr_in, int fq) const {
        int fr = fr_in; asm volatile("" : "+v"(fr));
        if constexpr (F8) asm volatile("s_nop 15\n\ts_nop 15\n\ts_nop 15" ::: "memory");
        const int pn = u.pn, row0 = u.pm * BM + wr * 64 + fr;
        if (pn == 10 || pn == 11 || (pn == 12 && wc < 2)) {
            const int cbase = (pn == 12) ? (C_KC + wc * 64) : (C_QC + (pn - 10) * 256 + wc * 64);
            const float sc = ((pn == 12) ? 1.0f : 0.125f) * A8;
#pragma unroll
            for (int ai = 0; ai < 2; ++ai)
#pragma unroll
                for (int m = 0; m < 4; ++m) { const int row = row0 + ai * HALF + m * 16, t = row & (SEQ - 1);
                    f32x4 o1[2], o2[2];
#pragma unroll
                    for (int n = 0; n < 2; ++n) { const f32x4 cs = *(const f32x4*)(ropec + t * 32 + 8 * fq + 4 * n), sn = *(const f32x4*)(ropes + t * 32 + 8 * fq + 4 * n);
                        const f32x4 x1 = acc[ai][0][m][n], x2 = acc[ai][1][m][n];
                        o1[n] = (x1 * cs - x2 * sn) * sc; o2[n] = (x2 * cs + x1 * sn) * sc; }
                    bf16_t* rowp = P + (size_t)row * NIN + cbase + 8 * fq;
                    *(u32x4*)(rowp) = pack8(o1[0], o1[1]); *(u32x4*)(rowp + 32) = pack8(o2[0], o2[1]); }
        } else if (pn == 12) {
#pragma unroll
            for (int ai = 0; ai < 2; ++ai)
#pragma unroll
                for (int m = 0; m < 4; ++m) { bf16_t* rowp = P + (size_t)(row0 + ai * HALF + m * 16) * NIN + C_VC + 32 * (wc - 2) + 8 * fq;
#pragma unroll
                    for (int bj = 0; bj < 2; ++bj) *(u32x4*)(rowp + bj * 64) = pack8(acc[ai][bj][m][0] * A8, acc[ai][bj][m][1] * A8); }
        } else if (pn == 9) {
#pragma unroll
            for (int ai = 0; ai < 2; ++ai)
#pragma unroll
                for (int m = 0; m < 4; ++m) { const int row = row0 + ai * HALF + m * 16, b = row >> 11, t = row & (SEQ - 1), c = t >> 5, s = t & 31;
#pragma unroll
                    for (int bj = 0; bj < 2; ++bj) { const int ch0 = bj * HALF + wc * 32 + 8 * fq, gg = ch0 >> 4, q0 = ch0 & 15;
                        *(u32x4*)(U2 + ((size_t)(gg * S5ROWS + b * S5NC + c)) * S5K + s * 16 + q0) = pack8(acc[ai][bj][m][0] * A8, acc[ai][bj][m][1] * A8); } }
        } else {
            const float sc = ((pn < 3) ? 0.125f : 1.0f) * A8; const bool sg = pn >= 13;
            if (sg) {
#pragma unroll
                for (int ai = 0; ai < 2; ++ai)
#pragma unroll
                    for (int m = 0; m < 4; ++m) { unsigned char* rowp = G8 + (size_t)(row0 + ai * HALF + m * 16) * (3 * DM) + (pn - 13) * BM + (wc * 4 + fq) * 16;
                        u32x2 gw[2];
#pragma unroll
                        for (int bj = 0; bj < 2; ++bj) { f32x4 v0 = acc[ai][bj][m][0], v1 = acc[ai][bj][m][1]; const float c = sc * -1.4426950408889634f;
#pragma unroll
                            for (int j = 0; j < 4; ++j) { v0[j] = __builtin_amdgcn_rcpf(1.0f + __builtin_amdgcn_exp2f(v0[j] * c)); v1[j] = __builtin_amdgcn_rcpf(1.0f + __builtin_amdgcn_exp2f(v1[j] * c)); }
                            gw[bj] = pack8_gate(v0, v1); }
                        __builtin_nontemporal_store((u32x4){gw[0].x, gw[0].y, gw[1].x, gw[1].y}, (u32x4*)rowp); }
            } else {
#pragma unroll
            for (int ai = 0; ai < 2; ++ai)
#pragma unroll
                for (int m = 0; m < 4; ++m) { bf16_t* rowp = P + (size_t)(row0 + ai * HALF + m * 16) * NIN + pn * BM + wc * 32 + 8 * fq;
#pragma unroll
                    for (int bj = 0; bj < 2; ++bj) { f32x4 v0 = acc[ai][bj][m][0] * sc, v1 = acc[ai][bj][m][1] * sc;
                        *(u32x4*)(rowp + bj * HALF) = pack8(v0, v1); } }
            }
        }
    }
};
using EpiInProj = EpiInProjT<false>;
struct EpiBranch {
    static constexpr bool PERM = true, HAS_MID = true, FP8 = false, HALFM = false; static constexpr int MID1 = 4, MID2 = 8;
    const unsigned char* G8; bf16_t* O;
    __device__ __forceinline__ void mid(f32x4 (&acc)[2][2][4][2], const Unit& u, int wr, int wc, int fr, int fq, int which) const {
        int fr_ = fr; asm volatile("" : "+v"(fr_));
        const int row0 = u.pm * BM + wr * 64 + fr_, col0 = u.pn * BM + (wc * 4 + fq) * 16;
        const unsigned char* gp = G8 + (size_t)row0 * (3 * DM) + which * DM + col0;
#pragma unroll
        for (int ai = 0; ai < 2; ++ai) {
            u32x2 wn[4][2], wd[4][2];
#pragma unroll
            for (int m = 0; m < 4; ++m) { const unsigned char* gq = gp + (size_t)(ai * HALF + m * 16) * (3 * DM);
                const u32x4 qn = *(const u32x4*)gq, qd = *(const u32x4*)(gq + DM);
                wn[m][0] = (u32x2){qn.x, qn.y}; wn[m][1] = (u32x2){qn.z, qn.w}; wd[m][0] = (u32x2){qd.x, qd.y}; wd[m][1] = (u32x2){qd.z, qd.w}; }
            asm volatile("" ::: "memory");
#pragma unroll
            for (int m = 0; m < 4; ++m)
#pragma unroll
                for (int bj = 0; bj < 2; ++bj) { f32x4 n0, n1, d0, d1; unpack8_u8(wn[m][bj], n0, n1); unpack8_u8(wd[m][bj], d0, d1);
#pragma unroll
                    for (int j = 0; j < 4; ++j) { acc[ai][bj][m][0][j] *= n0[j] * __builtin_amdgcn_rcpf(d0[j]); acc[ai][bj][m][1][j] *= n1[j] * __builtin_amdgcn_rcpf(d1[j]); } }
            asm volatile("" ::: "memory"); }
    }
    __device__ __forceinline__ void operator()(const f32x4 (&acc)[2][2][4][2], const Unit& u, int wr, int wc, int fr_in, int fq) const {
        int fr = fr_in; asm volatile("" : "+v"(fr));
        const int row0 = u.pm * BM + wr * 64 + fr, col0 = u.pn * BM + wc * 32 + 8 * fq;
        u32x2 wg[2][4][2];
#pragma unroll
        for (int ai = 0; ai < 2; ++ai)
#pragma unroll
            for (int m = 0; m < 4; ++m) { const u32x4 qg = *(const u32x4*)(G8 + (size_t)(row0 + ai * HALF + m * 16) * (3 * DM) + 2 * DM + u.pn * BM + (wc * 4 + fq) * 16);
                wg[ai][m][0] = (u32x2){qg.x, qg.y}; wg[ai][m][1] = (u32x2){qg.z, qg.w}; }
        asm volatile("" ::: "memory");
#pragma unroll
        for (int ai = 0; ai < 2; ++ai)
#pragma unroll
            for (int m = 0; m < 4; ++m) { const int row = row0 + ai * HALF + m * 16;
#pragma unroll
                for (int bj = 0; bj < 2; ++bj) { f32x4 g0, g1; unpack8_u8(wg[ai][m][bj], g0, g1);
                    *(u32x4*)(O + (size_t)row * DM + col0 + bj * HALF) = pack8(acc[ai][bj][m][0] * g0 * (1.0f / 256.0f), acc[ai][bj][m][1] * g1 * (1.0f / 256.0f)); } }
    }
};
struct EpiS5State {
    static constexpr bool PERM = false, HAS_MID = false, FP8 = false, HALFM = true; static constexpr int MID1 = -1, MID2 = -1;
    float* Sst;
    __device__ __forceinline__ void operator()(const f32x4 (&acc)[2][2][4][2], const Unit& u, int wr, int wc, int fr_in, int fq) const {
        int fr = fr_in; asm volatile("" : "+v"(fr));
        const int row0 = u.pm * HALF + wr * 64 + fr, col0 = wc * 32 + 4 * fq;
#pragma unroll
            for (int m = 0; m < 4; ++m) { float* rowp = Sst + (size_t)(row0 + m * 16) * 128 + col0;
#pragma unroll
                for (int n = 0; n < 2; ++n) *(f32x4*)(rowp + n * 16) = acc[0][0][m][n]; }
    }
};
struct EpiS5Main {
    static constexpr bool PERM = true, HAS_MID = false, FP8 = false, HALFM = true; static constexpr int MID1 = -1, MID2 = -1;
    const bf16_t* U2; const float* dskip; bf16_t* gact;
    __device__ __forceinline__ void operator()(const f32x4 (&acc)[2][2][4][2], const Unit& u, int wr, int wc, int fr_in, int fq) const {
        int fr = fr_in; asm volatile("" : "+v"(fr));
        const int gg = u.pm >> 3, rl0 = (u.pm & 7) * HALF + wr * 64 + fr, cl0 = (u.pn & 1) * BM + wc * 32 + 8 * fq;
        u32x4 wu[1][4][2];
        constexpr int ai = 0;
#pragma unroll
            for (int m = 0; m < 4; ++m)
#pragma unroll
                for (int bj = 0; bj < 2; ++bj) wu[ai][m][bj] = *(const u32x4*)(U2 + (size_t)(gg * S5ROWS + rl0 + m * 16) * S5K + cl0 + bj * HALF);
        asm volatile("" ::: "memory");
#pragma unroll
            for (int m = 0; m < 4; ++m) { const int rl = rl0 + m * 16, b = rl >> 6, c = rl & 63;
#pragma unroll
                for (int bj = 0; bj < 2; ++bj) { const int col = cl0 + bj * HALF, tau = col >> 4, p0 = col & 15, ch = gg * 16 + p0;
                    f32x4 u0, u1; unpack8(wu[ai][m][bj], u0, u1);
                    const f32x4 d0 = *(const f32x4*)(dskip + ch), d1 = *(const f32x4*)(dskip + ch + 4);
                    f32x4 y0 = acc[ai][bj][m][0] + d0 * u0, y1 = acc[ai][bj][m][1] + d1 * u1;
#pragma unroll
                    for (int j = 0; j < 4; ++j) { y0[j] = gelu_tanh_f(y0[j]); y1[j] = gelu_tanh_f(y1[j]); }
                    *(u32x4*)(gact + (size_t)(b * SEQ + c * S5T + tau) * 256 + ch) = pack8(y0, y1); } }
    }
};
struct EpiGLU {
    static constexpr bool PERM = true, HAS_MID = false, FP8 = false, HALFM = true; static constexpr int MID1 = -1, MID2 = -1;
    const bf16_t* gact; const float* bglu; bf16_t* ocat;
    __device__ __forceinline__ void operator()(const f32x4 (&acc)[2][2][4][2], const Unit& u, int wr, int wc, int fr_in, int fq) const {
        int fr = fr_in; asm volatile("" : "+v"(fr));
        const int row0 = u.pm * HALF + wr * 64 + fr, col0 = wc * 32 + 8 * fq;
        u32x4 wg[1][4][2];
        constexpr int ai = 0;
#pragma unroll
            for (int m = 0; m < 4; ++m)
#pragma unroll
                for (int bj = 0; bj < 2; ++bj) wg[ai][m][bj] = *(const u32x4*)(gact + (size_t)(row0 + m * 16) * 256 + col0 + bj * HALF);
        asm volatile("" ::: "memory");
#pragma unroll
            for (int m = 0; m < 4; ++m) { const int row = row0 + m * 16;
#pragma unroll
                for (int bj = 0; bj < 2; ++bj) { const int col = col0 + bj * HALF;
                    f32x4 g0, g1; unpack8(wg[ai][m][bj], g0, g1);
                    const f32x4 b0 = *(const f32x4*)(bglu + col), b1 = *(const f32x4*)(bglu + col + 4);
                    f32x4 o0, o1;
#pragma unroll
                    for (int j = 0; j < 4; ++j) { o0[j] = g0[j] * sigmoid_f(acc[ai][bj][m][0][j] + b0[j]); o1[j] = g1[j] * sigmoid_f(acc[ai][bj][m][1][j] + b1[j]); }
                    *(u32x4*)(ocat + (size_t)row * DM + 256 + col) = pack8(o0, o1); } }
    }
};
}

#define XB_TMO      128
#define XB_XCNT(j)  (256  + 64 * (j))
#define XB_XSUB(j)  (1280 + 64 * (j))
#define XB_XGEN(j)  (2304 + 64 * (j))
#define XB_TOP      3328
#define XB_TOPGEN   3392
#define XCD_BAR_WORDS 3456
#define XB_SPIN_CAP (1u << 18)

__device__ __forceinline__ unsigned xb_ld(unsigned* p)              { return __hip_atomic_load(p, __ATOMIC_RELAXED, __HIP_MEMORY_SCOPE_AGENT); }
__device__ __forceinline__ unsigned xb_add(unsigned* p, unsigned v) { return __hip_atomic_fetch_add(p, v, __ATOMIC_RELAXED, __HIP_MEMORY_SCOPE_AGENT); }
__device__ __forceinline__ unsigned xb_xcc_id() { return (unsigned)__builtin_amdgcn_s_getreg((3 << 11) | 20) & 0xFu; }
#define XB_SPIN(cond, bar) do { unsigned _sp = 0; while (cond) { __builtin_amdgcn_s_sleep(1); \
    if ((++_sp & 255u) == 0u) { if (xb_ld(&(bar)[XB_TMO])) break; if (_sp > XB_SPIN_CAP) { atomicAdd(&(bar)[XB_TMO], 1u); break; } } } } while (0)

struct XcdBarrier {
    unsigned* bar; unsigned x;
    volatile LAS unsigned* st;
};
__device__ __forceinline__ XcdBarrier xcd_barrier_post(unsigned* bar, volatile LAS unsigned* st) {
    XcdBarrier b; b.bar = bar; b.x = xb_xcc_id(); b.st = st;
    if (threadIdx.x == 0) (void)xb_add(&bar[XB_XCNT(b.x)], 1u);
    return b;
}
__device__ __forceinline__ void xcd_barrier_complete(unsigned* bar, unsigned x, unsigned& nloc, unsigned& nx) {
    const unsigned G = gridDim.x * gridDim.y * gridDim.z;
    unsigned sum, cnt, mine, sp = 0u;
    for (;;) {
        sum = 0u; cnt = 0u; mine = 0u;
#pragma unroll
        for (unsigned j = 0; j < 16; ++j) { const unsigned c = xb_ld(&bar[XB_XCNT(j)]); sum += c; cnt += (c > 0u) ? 1u : 0u; mine = (j == x) ? c : mine; }
        if (sum == G) break;
        __builtin_amdgcn_s_sleep(1);
        if ((++sp & 255u) == 0u) { if (xb_ld(&bar[XB_TMO])) break; if (sp > XB_SPIN_CAP) { atomicAdd(&bar[XB_TMO], 1u); break; } }
    }
    nloc = mine > 0u ? mine : 1u; nx = cnt > 0u ? cnt : 1u;
}
__device__ __forceinline__ void xcd_barrier(const XcdBarrier& b, const bool leader_thread) {
    asm volatile("s_waitcnt vmcnt(0)" ::: "memory");
    __syncthreads();
    if (leader_thread) {
        unsigned one = 1u; asm volatile("" : "+s"(one));
        unsigned* bar = b.bar;
        __builtin_amdgcn_s_waitcnt(0);
        unsigned nloc = b.st[0], nx = b.st[1];
        if (nloc == 0u) { xcd_barrier_complete(bar, b.x, nloc, nx); b.st[0] = nloc; b.st[1] = nx; }
        const unsigned old = xb_add(&bar[XB_XSUB(b.x)], one);
        const unsigned gen = old / nloc;
        if (old + 1u == (gen + 1u) * nloc) {
            __builtin_amdgcn_fence(__ATOMIC_RELEASE, "agent");
            asm volatile("s_waitcnt vmcnt(0)" ::: "memory");
            const unsigned og = xb_add(&bar[XB_TOP], one);
            const unsigned tg = og / nx;
            if (og + 1u == (tg + 1u) * nx) xb_add(&bar[XB_TOPGEN], one);
            else XB_SPIN(xb_ld(&bar[XB_TOPGEN]) == tg, bar);
            __builtin_amdgcn_fence(__ATOMIC_ACQUIRE, "agent");
            xb_add(&bar[XB_XGEN(b.x)], one);
            asm volatile("s_waitcnt vmcnt(0)" ::: "memory");
        } else {
            XB_SPIN(xb_ld(&bar[XB_XGEN(b.x)]) == gen, bar);
            __builtin_amdgcn_fence(__ATOMIC_ACQUIRE, "agent");
            asm volatile("s_waitcnt vmcnt(0)" ::: "memory");
        }
    }
    __syncthreads();
}

struct Args { const float* in[27]; float* out; unsigned char* ws; int ph_lo, ph_hi; };
enum { I_X = 0, I_NORM_MIX, I_W_IN, I_LAM_RE, I_LAM_IM, I_LOG_DT, I_B_RE, I_B_IM, I_C_RE, I_C_IM, I_S5D, I_WGLU, I_BGLU, I_SINKS, I_WBA, I_WBB, I_WBC, I_WOUT, I_NORM_FFN,
       I_FG, I_FU, I_FD, I_ROUTER, I_MG, I_MU, I_MD, I_NORM_FINAL };

struct Frame {
    LAS unsigned char* lds;
    volatile LAS unsigned* MISC;
    LAS int* moff;
    unsigned* ctl;
    int tid, lane, wave, G, bid;
    unsigned char* ws;
};

__device__ __forceinline__ const float* inptr(const Frame& F, int i) {
    const volatile LAS unsigned* t = (const volatile LAS unsigned*)(F.lds + LDSCTL_OFF + 1024) + 2 * i;
    const unsigned lo = __builtin_amdgcn_readfirstlane(t[0]), hi = __builtin_amdgcn_readfirstlane(t[1]);
    return (const float*)(const GAS float*)(((unsigned long long)hi << 32) | lo);
}
struct TItem { const float* src; bf16_t* dst; int N, ldw; float sc8; };
__device__ __forceinline__ void titem_load(const TItem& t, float (&v)[32], int lane) {
    const float* p = t.src + (size_t)(lane >> 5) * t.N + (lane & 31);
#pragma unroll
    for (int i = 0; i < 32; ++i) v[i] = __builtin_nontemporal_load(p + (size_t)(2 * i) * t.N);
}
__device__ __forceinline__ void titem_store(const TItem& t, const float (&v)[32], LAS float* scr, int lane) {
#pragma unroll
    for (int i = 0; i < 32; ++i) scr[(2 * i + (lane >> 5)) * 33 + (lane & 31)] = v[i];
    LDS_WAIT(); asm volatile("" ::: "memory");
    const int c = lane & 7;
#pragma unroll
    for (int j = 0; j < 4; ++j) { const int n = (lane >> 3) + 8 * j; const LAS float* s = scr + (8 * c) * 33 + n;
        if (t.sc8 != 0.f) { const float q = t.sc8;
            *(u32x2*)((unsigned char*)t.dst + (size_t)n * t.ldw + 8 * c) = pack8_fp8((f32x4){s[0 * 33] * q, s[1 * 33] * q, s[2 * 33] * q, s[3 * 33] * q}, (f32x4){s[4 * 33] * q, s[5 * 33] * q, s[6 * 33] * q, s[7 * 33] * q}); }
        else { u32x4 o; o.x = cvt_pk_bf16(s[0 * 33], s[1 * 33]); o.y = cvt_pk_bf16(s[2 * 33], s[3 * 33]); o.z = cvt_pk_bf16(s[4 * 33], s[5 * 33]); o.w = cvt_pk_bf16(s[6 * 33], s[7 * 33]);
            *(u32x4*)(t.dst + (size_t)n * t.ldw + 8 * c) = o; } }
    LDS_WAIT(); asm volatile("" ::: "memory");
}
template <class Dec>
__device__ __forceinline__ void convert_loop(Frame& F, int NIT, const Dec& dec) {
    LAS float* scr = (LAS float*)(F.lds + F.wave * 8704);
    const int NGW = F.G * NWAVES; int it = F.bid * NWAVES + F.wave;
    if (it >= NIT) return;
    TItem cur = dec(it); float a[32]; titem_load(cur, a, F.lane);
    for (;;) {
        const int nit = it + NGW; const bool has = nit < NIT; TItem nx = cur; float b[32];
        if (has) { nx = dec(nit); titem_load(nx, b, F.lane); }
        titem_store(cur, a, scr, F.lane);
        if (!has) break;
#pragma unroll
        for (int i = 0; i < 32; ++i) a[i] = b[i];
        cur = nx; it = nit;
    }
}
__device__ __forceinline__ int inproj_dest_row(int n0) {
    if (n0 >= C_QC && n0 < C_KC) { const int ub = C_QC + ((n0 - C_QC) >> 8) * 256, r = n0 - ub, hh = r >> 6, half = (r >> 5) & 1; return ub + half * 128 + 32 * hh; }
    if (n0 >= C_KC && n0 < C_VC) { const int r = n0 - C_KC, hh = r >> 6, half = (r >> 5) & 1; return C_KC + half * 128 + 32 * hh; }
    if (n0 >= C_VC && n0 < C_G)  { const int r = n0 - C_VC, hd = r >> 6, j = (r >> 5) & 1; return C_KC + 64 + 128 * hd + 32 * j; }
    return n0;
}
struct MixerDec { const float *win, *wba, *wbb, *wbc, *wout, *wglu; bf16_t *WinT, *WbrT, *WoutT, *WgluT; int in8;
    static constexpr int I_IN = 16 * 200, I_BA = 4 * 32, I_BC = 8 * 32, I_O = 16 * 32, I_GL = 4 * 8, NIT = I_IN + 2 * I_BA + I_BC + I_O + I_GL;
    __device__ __forceinline__ TItem operator()(int it) const { int r = it;
        if (r < I_IN) { const int k0 = 64 * (r / 200), n0 = 32 * (r % 200); return in8 ? TItem{win + (size_t)k0 * NIN + n0, (bf16_t*)((unsigned char*)WinT + (size_t)inproj_dest_row(n0) * DM + k0), NIN, DM, 64.0f}
                                                                                                 : TItem{win + (size_t)k0 * NIN + n0, WinT + (size_t)inproj_dest_row(n0) * DM + k0, NIN, DM, 0.f}; } r -= I_IN;
        if (r < I_BA) { const int k0 = 64 * (r / 32), n0 = 32 * (r % 32); return TItem{wba + (size_t)k0 * DM + n0, WbrT + (size_t)n0 * DM + k0, DM, DM, 0.f}; } r -= I_BA;
        if (r < I_BA) { const int k0 = 64 * (r / 32), n0 = 32 * (r % 32); return TItem{wbb + (size_t)k0 * DM + n0, WbrT + (size_t)n0 * DM + 256 + k0, DM, DM, 0.f}; } r -= I_BA;
        if (r < I_BC) { const int k0 = 64 * (r / 32), n0 = 32 * (r % 32); return TItem{wbc + (size_t)k0 * DM + n0, WbrT + (size_t)n0 * DM + 512 + k0, DM, DM, 0.f}; } r -= I_BC;
        if (r < I_O)  { const int k0 = 64 * (r / 32), n0 = 32 * (r % 32); return TItem{wout + (size_t)k0 * DM + n0, WoutT + (size_t)n0 * DM + k0, DM, DM, 0.f}; } r -= I_O;
        { const int k0 = 64 * (r / 8), n0 = 32 * (r % 8); return TItem{wglu + (size_t)k0 * 256 + n0, WgluT + (size_t)n0 * 256 + k0, 256, 256, 0.f}; } } };
__device__ __forceinline__ void convert_mixer_weights(Frame& F, int l) {
    MixerDec d{inptr(F, I_W_IN) + (size_t)l * DM * NIN, inptr(F, I_WBA) + (size_t)l * 256 * DM, inptr(F, I_WBB) + (size_t)l * 256 * DM, inptr(F, I_WBC) + (size_t)l * 512 * DM,
               inptr(F, I_WOUT) + (size_t)l * DM * DM, inptr(F, I_WGLU) + (size_t)l * 256 * 256,
               (bf16_t*)(F.ws + WS_WIN), (bf16_t*)(F.ws + WS_WBR), (bf16_t*)(F.ws + WS_WOUT), (bf16_t*)(F.ws + WS_WGLU), (IN8_MASK >> l) & 1};
    convert_loop(F, MixerDec::NIT, d);
}
struct FfnDec { const float *Wg, *Wu, *Wd; unsigned char *WguT, *WdT; int es; float sg, sd;
    static constexpr int I_G = 16 * 112, I_D = 56 * 32, I_E = 2 * I_G + I_D;
    __device__ __forceinline__ TItem operator()(int it) const { const int e = it / I_E; int r = it % I_E;
        if (r < I_G) { const int k0 = 64 * (r / 112), n0 = 32 * (r % 112); return TItem{Wg + (size_t)e * DM * DFF + (size_t)k0 * DFF + n0, (bf16_t*)(WguT + ((size_t)(e * 2 * DFF + (n0 >> 7) * 256 + (n0 & 127)) * DM + k0) * es), DFF, es == 1 ? DM : DM, es == 1 ? sg : 0.f}; } r -= I_G;
        if (r < I_G) { const int k0 = 64 * (r / 112), n0 = 32 * (r % 112); return TItem{Wu + (size_t)e * DM * DFF + (size_t)k0 * DFF + n0, (bf16_t*)(WguT + ((size_t)(e * 2 * DFF + (n0 >> 7) * 256 + 128 + (n0 & 127)) * DM + k0) * es), DFF, DM, es == 1 ? sg : 0.f}; } r -= I_G;
        { const int k0 = 64 * (r / 32), n0 = 32 * (r % 32); return TItem{Wd + (size_t)e * DFF * DM + (size_t)k0 * DM + n0, (bf16_t*)(WdT + ((size_t)(e * DM + n0) * DFF + k0) * es), DM, DFF, es == 1 ? sd : 0.f}; } } };
__device__ __forceinline__ void convert_ffn_weights(Frame& F, int l) {
    const bool moe = (l & 1); const int li = l >> 1, ne = moe ? NEXP : 1; const bool f8 = (FP8_MASK >> l) & 1;
    FfnDec d{moe ? inptr(F, I_MG) + (size_t)li * NEXP * DM * DFF : inptr(F, I_FG) + (size_t)li * DM * DFF,
             moe ? inptr(F, I_MU) + (size_t)li * NEXP * DM * DFF : inptr(F, I_FU) + (size_t)li * DM * DFF,
             moe ? inptr(F, I_MD) + (size_t)li * NEXP * DFF * DM : inptr(F, I_FD) + (size_t)li * DFF * DM,
             F.ws + WS_WGU, F.ws + WS_WD, f8 ? 1 : 2, 64.0f, 128.0f};
    convert_loop(F, ne * FfnDec::I_E, d);
}
__device__ __forceinline__ void rope_table(Frame& F) {
    float* rc = (float*)(F.ws + WS_ROPE); float* rs = rc + SEQ * 32;
    for (int idx = F.bid * NTHREADS + F.tid; idx < SEQ * 32; idx += F.G * NTHREADS) { const int t = idx >> 5, i = idx & 31;
        const float inv = exp2f(-(float)i * (17.194602975157967f / 32.0f));
        double rev = (double)t * (double)inv * 0.15915494309189535; rev -= floor(rev); const float rf = (float)rev;
        rc[idx] = __builtin_amdgcn_cosf(rf); rs[idx] = __builtin_amdgcn_sinf(rf); }
}
__device__ __forceinline__ void s5_prep(Frame& F, int l, int gg, int sub) {
    LAS float* apow = (LAS float*)F.lds;
    LAS float* Bb = apow + 33 * 64 * 2;
    LAS float* Cc = Bb + 64 * 16 * 2;
    LAS float* Kt = Cc + 16 * 64 * 2;
    const float* lam_re = inptr(F, I_LAM_RE) + (size_t)(l * 16 + gg) * 64; const float* lam_im = inptr(F, I_LAM_IM) + (size_t)(l * 16 + gg) * 64;
    const float dt = __expf(inptr(F, I_LOG_DT)[l * 16 + gg]);
    const float* bre = inptr(F, I_B_RE) + (size_t)(l * 16 + gg) * 64 * 16; const float* bim = inptr(F, I_B_IM) + (size_t)(l * 16 + gg) * 64 * 16;
    const float* cre = inptr(F, I_C_RE) + (size_t)(l * 16 + gg) * 16 * 64; const float* cim = inptr(F, I_C_IM) + (size_t)(l * 16 + gg) * 16 * 64;
    __syncthreads();
    for (int idx = F.tid; idx < 33 * 64; idx += NTHREADS) { const int k = idx >> 6, n = idx & 63; const float lr = lam_re[n], li = lam_im[n];
        const float mag = __expf(lr * dt * (float)k); double rev = (double)li * (double)dt * (double)k * 0.15915494309189535; rev -= floor(rev); const float rf = (float)rev;
        apow[idx * 2] = mag * __builtin_amdgcn_cosf(rf); apow[idx * 2 + 1] = mag * __builtin_amdgcn_sinf(rf); }
    for (int idx = F.tid; idx < 16 * 64; idx += NTHREADS) { Cc[idx * 2] = cre[idx]; Cc[idx * 2 + 1] = cim[idx]; }
    __syncthreads();
    for (int idx = F.tid; idx < 64 * 16; idx += NTHREADS) { const int n = idx >> 4; const float lr = lam_re[n], li = lam_im[n];
        const float are = apow[(64 + n) * 2], aim = apow[(64 + n) * 2 + 1], nr = are - 1.0f, ni = aim, den = lr * lr + li * li;
        const float zre = (nr * lr + ni * li) / den, zim = (ni * lr - nr * li) / den, br = bre[idx], bi = bim[idx];
        Bb[idx * 2] = zre * br - zim * bi; Bb[idx * 2 + 1] = zre * bi + zim * br; }
    __syncthreads();
    for (int idx = F.tid; idx < 32 * 32; idx += NTHREADS) { const int k = idx >> 5, pl = (idx >> 4) & 1, q = idx & 15, p = 2 * sub + pl; float s = 0.f;
        for (int n = 0; n < 64; ++n) { const float ar = apow[(k * 64 + n) * 2], ai = apow[(k * 64 + n) * 2 + 1], br = Bb[(n * 16 + q) * 2], bi = Bb[(n * 16 + q) * 2 + 1];
            const float tr = ar * br - ai * bi, ti = ar * bi + ai * br; s += Cc[(p * 64 + n) * 2] * tr - Cc[(p * 64 + n) * 2 + 1] * ti; }
        Kt[idx] = s; }
    __syncthreads();
    bf16_t* Toep = (bf16_t*)(F.ws + WS_TOEP) + (size_t)gg * 512 * S5K;
    for (int ci = F.tid; ci < 64 * 80; ci += NTHREADS) { const int rl = ci / 80, cc = ci % 80, t = rl >> 1, pl = rl & 1, p = 2 * sub + pl, row = t * 16 + p; float v[8];
        if (cc < 64) { const int sx = cc >> 1, q0 = (cc & 1) * 8;
#pragma unroll
            for (int j = 0; j < 8; ++j) v[j] = (t >= sx) ? Kt[(t - sx) * 32 + pl * 16 + q0 + j] : 0.f;
        } else { const int c2 = cc - 64, im = c2 >> 3, n0 = (c2 & 7) * 8;
#pragma unroll
            for (int j = 0; j < 8; ++j) { const int n = n0 + j; const float ar = apow[((t + 1) * 64 + n) * 2], ai = apow[((t + 1) * 64 + n) * 2 + 1], cr = Cc[(p * 64 + n) * 2], cim2 = Cc[(p * 64 + n) * 2 + 1];
                v[j] = im ? -(cr * ai + cim2 * ar) : (cr * ar - cim2 * ai); } }
        u32x4 o; o.x = cvt_pk_bf16(v[0], v[1]); o.y = cvt_pk_bf16(v[2], v[3]); o.z = cvt_pk_bf16(v[4], v[5]); o.w = cvt_pk_bf16(v[6], v[7]);
        *(u32x4*)(Toep + (size_t)row * S5K + cc * 8) = o; }
    bf16_t* Em = (bf16_t*)(F.ws + WS_E) + (size_t)gg * 256 * 512;
    for (int ci = F.tid; ci < 32 * 64; ci += NTHREADS) { const int row = 32 * sub + (ci >> 6), cc = ci & 63, sx = cc >> 1, q0 = (cc & 1) * 8; float v[8];
        if (row < 128) { const int im = row >> 6, n = row & 63; const float ar = apow[((31 - sx) * 64 + n) * 2], ai = apow[((31 - sx) * 64 + n) * 2 + 1];
#pragma unroll
            for (int j = 0; j < 8; ++j) { const float br = Bb[(n * 16 + q0 + j) * 2], bi = Bb[(n * 16 + q0 + j) * 2 + 1]; v[j] = im ? (ar * bi + ai * br) : (ar * br - ai * bi); }
        } else {
#pragma unroll
            for (int j = 0; j < 8; ++j) v[j] = 0.f; }
        u32x4 o; o.x = cvt_pk_bf16(v[0], v[1]); o.y = cvt_pk_bf16(v[2], v[3]); o.z = cvt_pk_bf16(v[4], v[5]); o.w = cvt_pk_bf16(v[6], v[7]);
        *(u32x4*)(Em + (size_t)row * 512 + cc * 8) = o; }
    if (sub == 0 && F.tid < 64) { float* aT = (float*)(F.ws + WS_AT) + gg * 128; aT[F.tid * 2] = apow[(32 * 64 + F.tid) * 2]; aT[F.tid * 2 + 1] = apow[(32 * 64 + F.tid) * 2 + 1]; }
    __syncthreads();
}

__device__ __forceinline__ void load_moe_off(Frame& F, int ls) {
    __syncthreads();
    if (F.tid < 8) { int zz = 0; asm volatile("" : "+v"(zz));
        F.moff[16 + F.tid] = (ls & 1) ? (int)__hip_atomic_load(F.ctl + CW_MOECNT + 16 * (ls >> 1) + F.tid, __ATOMIC_RELAXED, __HIP_MEMORY_SCOPE_AGENT) : ((F.tid == 0) ? MTOK + zz : zz); }
    __syncthreads();
    if (F.tid == 0) {
        int o = 0, fp = 0, np = 0; int zz = 0; asm volatile("" : "+v"(zz));
#pragma unroll 1
        for (int e = zz; e < 8; ++e) {
            const int c = F.moff[16 + e];
            F.moff[e] = o; F.moff[24 + e] = fp; o += (c + 255) & ~255; fp += c >> 8;
            if (c & 255) { F.moff[40 + np] = e; F.moff[48 + e] = np; ++np; } else F.moff[48 + e] = zz - 1; }
        F.moff[8] = o; F.moff[32] = fp; F.moff[33] = np;
    }
    __syncthreads();
}

constexpr int NORM_R = 4;
__device__ __forceinline__ void norm_phase(Frame& F, const void* xin_, int xbf, bf16_t* xout, const bf16_t* yb, int add_mode, const float* gain, bf16_t* hout, float* fout,
                                           const float* router, unsigned* gcnt, int* blkcnt = nullptr, int dry_in = 0, int h8 = 0) {
    int dry = dry_in; asm volatile("" : "+s"(dry));
    const int gw = F.bid * NWAVES + F.wave, NGW = F.G * NWAVES;
    const int* toke = (const int*)(F.ws + WS_TOKE); const int* tokp = (const int*)(F.ws + WS_TOKP); const float* tokw = (const float*)(F.ws + WS_TOKW);
    LAS float* rT = (LAS float*)F.lds;
    LAS int* lcnt = (LAS int*)(F.lds + 32768);
    LAS int* rec = (LAS int*)(F.lds + 32768 + 1024);
    if (router) {
        for (int idx = F.tid; idx < DM * NEXP; idx += NTHREADS) rT[(idx & 7) * DM + (idx >> 3)] = router[idx];
        if (F.tid < 64) lcnt[F.tid] = 0;
        __syncthreads();
    }
    f32x4 gn[4];
#pragma unroll
    for (int j = 0; j < 4; ++j) gn[j] = *(const f32x4*)(gain + 4 * F.lane + 256 * j);
    int iter = 0;
    constexpr int R = NORM_R;
    float eps_l = RMS_EPS; asm volatile("" : "+v"(eps_l));
    for (int m0 = gw * R; m0 < MTOK; m0 += NGW * R) {
        f32x4 v[R][4];
        if (xbf) {
#pragma unroll
            for (int rr = 0; rr < R; ++rr) { const u32x2* xr = (const u32x2*)((const bf16_t*)xin_ + (size_t)(m0 + rr) * DM) + F.lane;
#pragma unroll
                for (int j = 0; j < 4; ++j) { const u32x2 w = __builtin_nontemporal_load(xr + 64 * j); v[rr][j] = (f32x4){bf_lo(w.x), bf_hi(w.x), bf_lo(w.y), bf_hi(w.y)}; } }
        } else {
#pragma unroll
        for (int rr = 0; rr < R; ++rr) { const f32x4* xr = (const f32x4*)((const float*)xin_ + (size_t)(m0 + rr) * DM) + F.lane;
#pragma unroll
            for (int j = 0; j < 4; ++j) v[rr][j] = __builtin_nontemporal_load(xr + 64 * j); } }
        if (add_mode == 1) {
            u32x2 w[R][4];
#pragma unroll
            for (int rr = 0; rr < R; ++rr) { const u32x2* yr = (const u32x2*)(yb + (size_t)(m0 + rr) * DM) + F.lane;
#pragma unroll
                for (int j = 0; j < 4; ++j) w[rr][j] = __builtin_nontemporal_load(yr + 64 * j); }
#pragma unroll
            for (int rr = 0; rr < R; ++rr)
#pragma unroll
                for (int j = 0; j < 4; ++j) v[rr][j] += (f32x4){bf_lo(w[rr][j].x), bf_hi(w[rr][j].x), bf_lo(w[rr][j].y), bf_hi(w[rr][j].y)};
        } else if (add_mode == 2) {
            u32x2 wa[R][4], wb[R][4]; float w0[R], w1[R];
#pragma unroll
            for (int rr = 0; rr < R; ++rr) { const int m = m0 + rr; const int e0 = toke[2 * m], e1 = toke[2 * m + 1]; w0[rr] = tokw[2 * m]; w1[rr] = tokw[2 * m + 1];
                const int d0 = F.moff[e0] + tokp[2 * m], d1 = F.moff[e1] + tokp[2 * m + 1];
                const u32x2* y0 = (const u32x2*)(yb + (size_t)d0 * DM) + F.lane; const u32x2* y1 = (const u32x2*)(yb + (size_t)d1 * DM) + F.lane;
#pragma unroll
                for (int j = 0; j < 4; ++j) { wa[rr][j] = __builtin_nontemporal_load(y0 + 64 * j); wb[rr][j] = __builtin_nontemporal_load(y1 + 64 * j); }
            }
#pragma unroll
            for (int rr = 0; rr < R; ++rr)
#pragma unroll
                for (int j = 0; j < 4; ++j) { const u32x2 a = wa[rr][j], b = wb[rr][j];
                    v[rr][j] += (f32x4){bf_lo(a.x), bf_hi(a.x), bf_lo(a.y), bf_hi(a.y)} * w0[rr] + (f32x4){bf_lo(b.x), bf_hi(b.x), bf_lo(b.y), bf_hi(b.y)} * w1[rr]; }
        }
        if (add_mode && !dry && xout) {
#pragma unroll
            for (int rr = 0; rr < R; ++rr) { u32x2* xo = (u32x2*)(xout + (size_t)(m0 + rr) * DM) + F.lane;
#pragma unroll
                for (int j = 0; j < 4; ++j) { u32x2 w; w.x = cvt_pk_bf16(v[rr][j].x, v[rr][j].y); w.y = cvt_pk_bf16(v[rr][j].z, v[rr][j].w); __builtin_nontemporal_store(w, xo + 64 * j); } } }
        float ss[R];
#pragma unroll
        for (int rr = 0; rr < R; ++rr) { ss[rr] = 0.f;
#pragma unroll
            for (int j = 0; j < 4; ++j) ss[rr] += (v[rr][j].x * v[rr][j].x + v[rr][j].y * v[rr][j].y) + (v[rr][j].z * v[rr][j].z + v[rr][j].w * v[rr][j].w); }
#pragma unroll
        for (int o = 1; o < 64; o <<= 1) {
#pragma unroll
            for (int rr = 0; rr < R; ++rr) ss[rr] += shfl_xor_l(ss[rr], o, F.lane); }
#pragma unroll
        for (int rr = 0; rr < R; ++rr) { const float rs = rsqrtf(ss[rr] * (1.0f / DM) + eps_l);
#pragma unroll
            for (int j = 0; j < 4; ++j) v[rr][j] = v[rr][j] * rs * gn[j]; }
        if (dry) { float z = 0.f;
#pragma unroll
            for (int rr = 0; rr < R; ++rr)
#pragma unroll
                for (int j = 0; j < 4; ++j) z += v[rr][j].x + v[rr][j].y + v[rr][j].z + v[rr][j].w;
            if (z == 1.2345e-30f) ((float*)(F.ws + WS_LSE))[0] = z; }
        else if (fout) {
#pragma unroll
            for (int rr = 0; rr < R; ++rr) { f32x4* fo = (f32x4*)(fout + (size_t)(m0 + rr) * DM) + F.lane;
#pragma unroll
                for (int j = 0; j < 4; ++j) __builtin_nontemporal_store(v[rr][j], fo + 64 * j); } }
        else if (h8) {
#pragma unroll
            for (int rr = 0; rr < R; ++rr) { unsigned* ho = (unsigned*)((unsigned char*)hout + (size_t)(m0 + rr) * DM) + F.lane;
#pragma unroll
                for (int j = 0; j < 4; ++j) { const u32x2 w = pack8_fp8(v[rr][j] * 8.0f, (f32x4){0.f, 0.f, 0.f, 0.f}); ho[64 * j] = w.x; } } }
        else {
#pragma unroll
            for (int rr = 0; rr < R; ++rr) { u32x2* ho = (u32x2*)(hout + (size_t)(m0 + rr) * DM) + F.lane;
#pragma unroll
                for (int j = 0; j < 4; ++j) { u32x2 w; w.x = cvt_pk_bf16(v[rr][j].x, v[rr][j].y); w.y = cvt_pk_bf16(v[rr][j].z, v[rr][j].w); ho[64 * j] = w; } } }
        if (router && !dry) {
#pragma unroll
            for (int rr = 0; rr < R; ++rr, ++iter) { const int m = m0 + rr;
                float lg[8];
#pragma unroll
                for (int e = 0; e < 8; ++e) { float s = 0.f;
#pragma unroll
                    for (int j = 0; j < 4; ++j) { const f32x4 r = *(const LAS f32x4*)(rT + e * DM + 4 * F.lane + 256 * j); s += (v[rr][j].x * r.x + v[rr][j].y * r.y) + (v[rr][j].z * r.z + v[rr][j].w * r.w); }
                    lg[e] = s; }
#pragma unroll
                for (int o = 1; o < 64; o <<= 1) {
#pragma unroll
                    for (int e = 0; e < 8; ++e) lg[e] += shfl_xor_l(lg[e], o, F.lane); }
                int e0 = 0; float v0 = lg[0];
#pragma unroll
                for (int e = 1; e < 8; ++e) if (lg[e] > v0) { v0 = lg[e]; e0 = e; }
                int e1 = -1; float v1 = -INFINITY;
#pragma unroll
                for (int e = 0; e < 8; ++e) if (e != e0 && lg[e] > v1) { v1 = lg[e]; e1 = e; }
                if (F.lane == 0) { const float w0 = 1.0f / (1.0f + __expf(v1 - v0));
                    float* tw = (float*)(F.ws + WS_TOKW); tw[2 * m] = w0; tw[2 * m + 1] = 1.0f - w0;
                    LAS int* wc_ = lcnt + F.wave * 8; const int r0 = wc_[e0]; wc_[e0] = r0 + 1; const int r1 = wc_[e1]; wc_[e1] = r1 + 1;
                    LAS int* rc = rec + (F.wave * 64 + (iter & 63)) * 4; rc[0] = m; rc[1] = e0 | (e1 << 8); rc[2] = r0; rc[3] = r1; }
            }
        }
    }
    if (router && !dry) {
        LAS int* niter = lcnt + 128;
        if (F.lane == 0) niter[F.wave] = iter;
        __syncthreads();
        if (F.tid < 64) { const int w = F.tid >> 3, e = F.tid & 7; int b = 0; for (int w2 = 0; w2 < w; ++w2) b += lcnt[w2 * 8 + e]; lcnt[64 + F.tid] = b; }
        if (F.tid < 8) { int t = 0; for (int w2 = 0; w2 < 8; ++w2) t += lcnt[w2 * 8 + F.tid];
            blkcnt[F.bid * 8 + F.tid] = t; __hip_atomic_fetch_add(gcnt + F.tid, (unsigned)t, __ATOMIC_RELAXED, __HIP_MEMORY_SCOPE_AGENT); }
        __syncthreads();
        int* te = (int*)(F.ws + WS_TOKE); int* tp = (int*)(F.ws + WS_TOKP);
        { const int w = F.tid >> 6, i = F.tid & 63; if (i < niter[w]) { const LAS int* rc = rec + (w * 64 + i) * 4; const int m = rc[0], e0 = rc[1] & 255, e1 = rc[1] >> 8;
            te[2 * m] = e0; te[2 * m + 1] = e1; tp[2 * m] = lcnt[64 + w * 8 + e0] + rc[2]; tp[2 * m + 1] = lcnt[64 + w * 8 + e1] + rc[3]; } }
        __syncthreads();
    }
}

__device__ __forceinline__ void moe_finalize(Frame& F, const int* blkcnt) {
    LAS int* bb = (LAS int*)(F.lds + 32768);
    __syncthreads();
    { const int e = F.tid & 7, part = F.tid >> 3; int s0 = 0;
#pragma unroll
        for (int k = 0; k < 16; ++k) { const int j = part + 64 * k; if (j < F.bid) s0 += blkcnt[j * 8 + e]; }
        bb[64 + F.tid] = s0; }
    __syncthreads();
    if (F.tid < 8) { int s1 = 0; for (int p = 0; p < 64; ++p) s1 += bb[64 + p * 8 + F.tid]; bb[F.tid] = s1; }
    __syncthreads();
    const int* te = (const int*)(F.ws + WS_TOKE); int* tp = (int*)(F.ws + WS_TOKP); int* trw = (int*)(F.ws + WS_TOKROW);
    const int NGW = F.G * NWAVES;
    for (int idx = F.tid; idx < NWAVES * 64; idx += NTHREADS) { const int w = idx >> 6, i = idx & 63, it = i / NORM_R, rr = i % NORM_R;
        const long m0 = (long)(F.bid * NWAVES + w) * NORM_R + (long)it * NGW * NORM_R; if (m0 >= MTOK) continue; const int m = (int)m0 + rr;
        const int e0 = te[2 * m], e1 = te[2 * m + 1], p0 = bb[e0] + tp[2 * m], p1 = bb[e1] + tp[2 * m + 1];
        tp[2 * m] = p0; tp[2 * m + 1] = p1; trw[(size_t)e0 * MTOK + p0] = m; trw[(size_t)e1 * MTOK + p1] = m; }
}

__device__ __forceinline__ void moe_gather(Frame& F) {
    const int gw = F.bid * NWAVES + F.wave, NGW = F.G * NWAVES;
    const int* toke = (const int*)(F.ws + WS_TOKE); const int* tokp = (const int*)(F.ws + WS_TOKP);
    const bf16_t* h = (const bf16_t*)(F.ws + WS_H); bf16_t* hs = (bf16_t*)(F.ws + WS_Y);
    for (int m = gw; m < MTOK; m += NGW) {
        const u32x4* src = (const u32x4*)(h + (size_t)m * DM) + F.lane; const u32x4 a = src[0], b = src[64];
        const int d0 = F.moff[toke[2 * m]] + tokp[2 * m], d1 = F.moff[toke[2 * m + 1]] + tokp[2 * m + 1];
        u32x4* o0 = (u32x4*)(hs + (size_t)d0 * DM) + F.lane; u32x4* o1 = (u32x4*)(hs + (size_t)d1 * DM) + F.lane;
        o0[0] = a; o0[64] = b; o1[0] = a; o1[64] = b;
    }
}

__device__ __forceinline__ int crow(int r, int hi) { return (r & 3) + 8 * (r >> 2) + 4 * hi; }
__device__ __forceinline__ s16x4 vtr(const LAS unsigned char* p) { return __builtin_bit_cast(s16x4, __builtin_amdgcn_ds_read_tr16_b64_v4i16((LAS v4i16_t*)p)); }
__device__ __forceinline__ void attn_phase(Frame& F, int l, int dry_in = 0) {
    int dry = dry_in; asm volatile("" : "+s"(dry));
    int tid_ = F.tid; asm volatile("" : "+v"(tid_));
    const int hw = F.wave >> 2, sw = F.wave & 3, t256 = tid_ & 255, lane = tid_ & 63, r = lane & 31, h = lane >> 5;
    LAS unsigned char* Kimg = F.lds + hw * 65536; LAS unsigned char* Vimg = Kimg + 32768;
    bf16_t* P = (bf16_t*)(F.ws + WS_PROJ); bf16_t* ocat = (bf16_t*)(F.ws + WS_OCAT); float* lse = (float*)(F.ws + WS_LSE);
    const float LOG2E = 1.4426950408889634f;
    const int rx = (r >> 1) & 7;
    int kofs[4];
#pragma unroll
    for (int ds = 0; ds < 4; ++ds) kofs[ds] = (32 * sw + r) * 128 + (((2 * ds + h) ^ rx) * 16);
    const int gi = lane >> 4, i16 = lane & 15, q = i16 >> 2, p = i16 & 3, xq = (q >> 1) & 1;
    const int vbase = (32 * sw + 4 * h + q) * 128 + ((2 * (gi & 1) + (p >> 1)) * 16) + (p & 1) * 8;
    int vofs[2];
#pragma unroll
    for (int db = 0; db < 2; ++db) vofs[db] = vbase + ((db ^ xq) * 64);
    for (int u = F.bid; u < 2560; u += F.G) {
        const int ub = u & 255, set = (u >> 8) * 8 + (ub & 7), w = (ub >> 3) * 2 + hw;
        int dl, nbk, qcol, kcol, vcol, hd, grp, blk; float sink = -INFINITY; bool isC;
        if (set >= 32) { const int gi = (set - 32) * 4 + (w >> 4); grp = gi >> 6; hd = (gi >> 4) & 3; blk = (gi & 15) * 16 + (w & 15); dl = (grp == 0) ? 1 : (grp == 1 ? 4 : 16); nbk = 16 / dl;
            qcol = C_QA + grp * 256 + hd * 64; kcol = C_KA + grp * 256 + hd * 64; vcol = C_VA + grp * 256 + hd * 64; isC = false; }
        else { grp = 3; hd = (set >> 4) * 4 + (w & 3); blk = (set & 15) * 16 + (w >> 2); dl = 1; nbk = 16; qcol = C_QC + hd * 64; kcol = C_KC + (hd >> 2) * 64; vcol = C_VC + (hd >> 2) * 64; isC = true;
            sink = inptr(F, I_SINKS)[l * 8 + hd]; }
        const int b = blk >> 4, within = blk & 15, ph = within / nbk, nb = within % nbk, tok0 = b * SEQ + ph;
        __syncthreads();
        u32x4 kreg[8], vreg[8];
#pragma unroll
        for (int it = 0; it < 8; ++it) { const int ci = it * 256 + t256, kl = ci >> 3, ch = ci & 7;
            if (nb > 0 || kl >= 128) { const size_t tok = (size_t)tok0 + (size_t)(nb * 128 - 128 + kl) * dl; const bf16_t* rp = P + tok * NIN + ch * 8;
                kreg[it] = *(const u32x4*)(rp + kcol); vreg[it] = *(const u32x4*)(rp + vcol); }
            else { kreg[it] = (u32x4){0u, 0u, 0u, 0u}; vreg[it] = (u32x4){0u, 0u, 0u, 0u}; } }
        const size_t qtok = (size_t)tok0 + (size_t)(nb * 128 + sw * 32 + r) * dl;
        bf16x8 qf[4];
#pragma unroll
        for (int ds = 0; ds < 4; ++ds) qf[ds] = *(const bf16x8*)(P + qtok * NIN + qcol + 16 * ds + 8 * h);
#pragma unroll
        for (int it = 0; it < 8; ++it) { const int ci = it * 256 + t256, kl = ci >> 3, ch = ci & 7;
            *(LAS u32x4*)(Kimg + kl * 128 + ((ch ^ ((kl >> 1) & 7)) * 16)) = kreg[it];
            *(LAS u32x4*)(Vimg + kl * 128 + ((ch ^ ((kl & 2) << 1)) * 16)) = vreg[it]; }
        __syncthreads();
        f32x16 sb[5];
#pragma unroll
        for (int kb = 0; kb < 5; ++kb) {
            const bool valid = (nb > 0) || (sw + kb >= 4);
            f32x16 x;
#pragma unroll
            for (int i = 0; i < 16; ++i) x[i] = 0.f;
            if (valid) {
#pragma unroll
                for (int ds = 0; ds < 4; ++ds) { const bf16x8 kf = *(const LAS bf16x8*)(Kimg + kofs[ds] + kb * 4096); x = __builtin_amdgcn_mfma_f32_32x32x16_bf16(kf, qf[ds], x, 0, 0, 0); }
                if (kb == 0) {
#pragma unroll
                    for (int i = 0; i < 16; ++i) if (crow(i, h) < r) x[i] = -INFINITY; }
                if (kb == 4) {
#pragma unroll
                    for (int i = 0; i < 16; ++i) if (crow(i, h) > r) x[i] = -INFINITY; }
            } else {
#pragma unroll
                for (int i = 0; i < 16; ++i) x[i] = -INFINITY; }
            sb[kb] = x;
        }
        float mx = sink;
#pragma unroll
        for (int kb = 0; kb < 5; ++kb)
#pragma unroll
            for (int i = 0; i < 16; ++i) mx = fmaxf(mx, sb[kb][i]);
        mx = fmaxf(mx, shfl_xor_l(mx, 32, lane));
        float lsum = 0.f; const float nmx = -mx * LOG2E;
#pragma unroll
        for (int kb = 0; kb < 5; ++kb)
#pragma unroll
            for (int i = 0; i < 16; ++i) { const float pv = __builtin_amdgcn_exp2f(__builtin_fmaf(sb[kb][i], LOG2E, nmx)); sb[kb][i] = pv; lsum += pv; }
        lsum += shfl_xor_l(lsum, 32, lane);
        if (isC) lsum += __builtin_amdgcn_exp2f((sink - mx) * LOG2E);
        f32x16 o[2];
#pragma unroll
        for (int db = 0; db < 2; ++db)
#pragma unroll
            for (int i = 0; i < 16; ++i) o[db][i] = 0.f;
#pragma unroll
        for (int kb = 0; kb < 5; ++kb) {
            const bool valid = (nb > 0) || (sw + kb >= 4);
            if (valid) {
#pragma unroll
                for (int s = 0; s < 2; ++s) {
                    u32x4 pw; pw.x = cvt_pk_bf16(sb[kb][8 * s + 0], sb[kb][8 * s + 1]); pw.y = cvt_pk_bf16(sb[kb][8 * s + 2], sb[kb][8 * s + 3]);
                    pw.z = cvt_pk_bf16(sb[kb][8 * s + 4], sb[kb][8 * s + 5]); pw.w = cvt_pk_bf16(sb[kb][8 * s + 6], sb[kb][8 * s + 7]);
                    const bf16x8 pb = __builtin_bit_cast(bf16x8, pw);
#pragma unroll
                    for (int db = 0; db < 2; ++db) {
                        const s16x4 lo = vtr(Vimg + vofs[db] + kb * 4096 + s * 2048), hi = vtr(Vimg + vofs[db] + kb * 4096 + s * 2048 + 1024);
                        const bf16x8 va = (bf16x8){lo[0], lo[1], lo[2], lo[3], hi[0], hi[1], hi[2], hi[3]};
                        o[db] = __builtin_amdgcn_mfma_f32_32x32x16_bf16(va, pb, o[db], 0, 0, 0);
                    }
                }
            }
        }
        const float inv = 1.0f / lsum;
        if (dry) continue;
        bf16_t* op = isC ? (ocat + qtok * DM + 512 + hd * 64) : (P + qtok * NIN + qcol);
#pragma unroll
        for (int db = 0; db < 2; ++db)
#pragma unroll
            for (int ip = 0; ip < 2; ++ip) { u32x2 w[2];
#pragma unroll
                for (int e = 0; e < 2; ++e) { const int ig = 2 * ip + e; w[e].x = cvt_pk_bf16(o[db][4 * ig] * inv, o[db][4 * ig + 1] * inv); w[e].y = cvt_pk_bf16(o[db][4 * ig + 2] * inv, o[db][4 * ig + 3] * inv); }
                unsigned a0 = w[0].x, a1 = w[0].y, b0 = w[1].x, b1 = w[1].y; swap32(a0, b0); swap32(a1, b1);
                *(u32x4*)(op + 32 * db + 16 * ip + 8 * h) = (u32x4){a0, a1, b0, b1}; }
        if (!isC && h == 0) lse[((size_t)grp * MTOK + qtok) * 4 + hd] = mx + __logf(lsum);
    }
    __syncthreads();
}

__device__ __forceinline__ void scan_combine_phase(Frame& F) {
    bf16_t* U2 = (bf16_t*)(F.ws + WS_U2); const float* Sst = (const float*)(F.ws + WS_SST); const float* aTt = (const float*)(F.ws + WS_AT);
    if (F.wave == 0) {
        for (int pr = F.bid; pr < 256; pr += F.G) { const int b = pr >> 4, gg = pr & 15, n = F.lane;
            const float ar = aTt[gg * 128 + 2 * n], ai = aTt[gg * 128 + 2 * n + 1];
            float hr = 0.f, hi = 0.f;
            const size_t row0 = (size_t)gg * S5ROWS + b * S5NC;
#pragma unroll 1
            for (int c0 = 0; c0 < S5NC; c0 += 16) { float sr[16], si[16];
#pragma unroll
                for (int j = 0; j < 16; ++j) { sr[j] = Sst[(row0 + c0 + j) * 128 + n]; si[j] = Sst[(row0 + c0 + j) * 128 + 64 + n]; }
#pragma unroll
                for (int j = 0; j < 16; ++j) { bf16_t* up = U2 + (row0 + c0 + j) * S5K + 512 + n;
                    up[0] = (bf16_t)(cvt_pk_bf16(hr, 0.f) & 0xffffu); up[64] = (bf16_t)(cvt_pk_bf16(hi, 0.f) & 0xffffu);
                    const float nr = ar * hr - ai * hi + sr[j], ni = ar * hi + ai * hr + si[j]; hr = nr; hi = ni; } }
        }
    }
    const bf16_t* P = (const bf16_t*)(F.ws + WS_PROJ); bf16_t* ocat = (bf16_t*)(F.ws + WS_OCAT); const float* lse = (const float*)(F.ws + WS_LSE);
    for (size_t it = (size_t)F.bid * NTHREADS + F.tid; it < (size_t)MTOK * 32; it += (size_t)F.G * NTHREADS) { const size_t tok = it >> 5; const int c8 = (int)(it & 31), hd = c8 >> 3;
        const float l0 = lse[(0 * (size_t)MTOK + tok) * 4 + hd], l1 = lse[(1 * (size_t)MTOK + tok) * 4 + hd], l2 = lse[(2 * (size_t)MTOK + tok) * 4 + hd];
        const float mm = fmaxf(l0, fmaxf(l1, l2)); float w0 = __expf(l0 - mm), w1 = __expf(l1 - mm), w2 = __expf(l2 - mm); const float iv = __builtin_amdgcn_rcpf(w0 + w1 + w2); w0 *= iv; w1 *= iv; w2 *= iv;
        const bf16_t* pp = P + tok * NIN + C_QA + c8 * 8;
        f32x4 a0, a1, b0, b1, c0, c1; unpack8(*(const u32x4*)(pp), a0, a1); unpack8(*(const u32x4*)(pp + 256), b0, b1); unpack8(*(const u32x4*)(pp + 512), c0, c1);
        *(u32x4*)(ocat + tok * DM + c8 * 8) = pack8(a0 * w0 + b0 * w1 + c0 * w2, a1 * w0 + b1 * w1 + c1 * w2); }
}

__device__ __forceinline__ void splitk_reduce(Frame& F) {
    const int np = F.moff[33]; const int gw = F.bid * NWAVES + F.wave, NGW = F.G * NWAVES;
    bf16_t* y = (bf16_t*)(F.ws + WS_Y); const bf16_t* part = (const bf16_t*)(F.ws + WS_YPART);
    for (int it = gw; it < np * 256; it += NGW) { const int pi = it >> 8, r = it & 255, e = F.moff[40 + pi], c = F.moff[16 + e];
        if (r >= (c & 255)) continue;
        u32x2* yr = (u32x2*)(y + (size_t)(F.moff[e] + (c & ~255) + r) * DM) + F.lane;
        u32x2 w[7][4];
#pragma unroll
        for (int j = 0; j < 4; ++j) w[0][j] = yr[64 * j];
#pragma unroll
        for (int ks = 0; ks < 6; ++ks) { const u32x2* pr = (const u32x2*)(part + ((size_t)ks * 2048 + pi * 256 + r) * DM) + F.lane;
#pragma unroll
            for (int j = 0; j < 4; ++j) w[ks + 1][j] = pr[64 * j]; }
#pragma unroll
        for (int j = 0; j < 4; ++j) { f32x4 a = (f32x4){0.f, 0.f, 0.f, 0.f};
#pragma unroll
            for (int ks = 0; ks < 7; ++ks) a += (f32x4){bf_lo(w[ks][j].x), bf_hi(w[ks][j].x), bf_lo(w[ks][j].y), bf_hi(w[ks][j].y)};
            u32x2 o; o.x = cvt_pk_bf16(a[0], a[1]); o.y = cvt_pk_bf16(a[2], a[3]); yr[64 * j] = o; }
    }
}

__global__ void __launch_bounds__(NTHREADS, 2) trunk_fwd(Args args) {
    extern __shared__ __attribute__((aligned(16))) unsigned char lds_raw[];
    Frame F;
    F.lds = (LAS unsigned char*)lds_raw;
    F.MISC = (volatile LAS unsigned*)(F.lds + LDSCTL_OFF + 320);
    F.moff = (LAS int*)(F.lds + LDSCTL_OFF + 512);
    F.tid = threadIdx.x; F.lane = F.tid & 63; F.wave = __builtin_amdgcn_readfirstlane(F.tid >> 6);
    F.G = gridDim.x; F.bid = blockIdx.x; F.ws = args.ws; F.ctl = (unsigned*)(args.ws + WS_CTL);
    for (int u = F.tid; u < (LDS_BYTES - LDSCTL_OFF) / 4; u += NTHREADS) ((LAS unsigned*)(F.lds + LDSCTL_OFF))[u] = 0u;
    __syncthreads();
    if (F.tid == 0) { LAS unsigned long long* tab = (LAS unsigned long long*)(F.lds + LDSCTL_OFF + 1024);
#pragma unroll
        for (int i = 0; i < 27; ++i) tab[i] = (unsigned long long)args.in[i]; }
    __syncthreads();
    const int lo = args.ph_lo, hi = args.ph_hi; const int wave0 = F.wave, bid0 = F.bid, grid0 = F.G; unsigned char* const ws0 = F.ws;
    XcdBarrier bar; bar.bar = F.ctl + CW_BAR; bar.x = 0; bar.st = nullptr;
    if (hi - lo > 1) bar = xcd_barrier_post(F.ctl + CW_BAR, F.MISC + 8);
#define IN(k) (lo <= (k) && (k) < hi)
#define REFRESH() do { int l_; asm volatile("v_mbcnt_lo_u32_b32 %0, -1, 0\n\tv_mbcnt_hi_u32_b32 %0, -1, %0" : "=v"(l_)); F.lane = l_; int w_ = wave0, b_ = bid0, g_ = grid0; unsigned long long p_ = (unsigned long long)ws0; asm volatile("" : "+s"(w_), "+s"(b_), "+s"(g_), "+s"(p_)); F.wave = w_; F.bid = b_; F.G = g_; F.ws = (unsigned char*)(GAS unsigned char*)p_; F.ctl = (unsigned*)(GAS unsigned*)p_; F.tid = w_ * 64 + l_; } while (0)
#define SEAM(k) do { if ((k) + 1 < hi) { REFRESH(); xcd_barrier(bar, F.tid == 0); if (PRB(11)) { REFRESH(); xcd_barrier(bar, F.tid == 0); REFRESH(); xcd_barrier(bar, F.tid == 0); } } } while (0)
#define Hb ((bf16_t*)(F.ws + WS_H))
#define Xb ((bf16_t*)(F.ws + WS_XB))
#define Pb ((bf16_t*)(F.ws + WS_PROJ))
#define Ocat ((bf16_t*)(F.ws + WS_OCAT))
#define Merged ((bf16_t*)(F.ws + WS_MERGED))
#define U2 ((bf16_t*)(F.ws + WS_U2))
#define Sst ((float*)(F.ws + WS_SST))
#define Gact ((bf16_t*)(F.ws + WS_GACT))
#define Hid ((bf16_t*)(F.ws + WS_HID))
#define Yb ((bf16_t*)(F.ws + WS_Y))
#define ropec ((const float*)(F.ws + WS_ROPE))
#define ropes ((const float*)(F.ws + WS_ROPE) + SEQ * 32)

#pragma unroll 1
    for (int l = 0; l < DEPTH; ++l) {
        const int pb = PPL * l; const bool moe = (l & 1);
        if (PHM(0) && IN(pb + 0)) { REFRESH();
            if (l == 0) rope_table(F);
            for (int rep = 0; rep < 1 + PRB(0); ++rep) {
            for (int wi = F.bid; wi < 128; wi += F.G) s5_prep(F, l, wi >> 3, wi & 7);
            convert_mixer_weights(F, l); }
            __syncthreads();
            if (l == 0) { norm_phase(F, inptr(F, I_X), 0, nullptr, nullptr, 0, inptr(F, I_NORM_MIX), Hb, nullptr, nullptr, nullptr, nullptr, 0, IN8_MASK & 1); if (PRB(2)) norm_phase(F, inptr(F, I_X), 0, nullptr, nullptr, 0, inptr(F, I_NORM_MIX), Hb, nullptr, nullptr, nullptr, nullptr, 1); }
            else { load_moe_off(F, l - 1); norm_phase(F, Xb, 1, Xb, Yb, ((l - 1) & 1) ? 2 : 1, inptr(F, I_NORM_MIX) + l * DM, Hb, nullptr, nullptr, nullptr, nullptr, 0, (IN8_MASK >> l) & 1);
                if (PRB(2)) norm_phase(F, Xb, 1, Xb, Yb, ((l - 1) & 1) ? 2 : 1, inptr(F, I_NORM_MIX) + l * DM, Hb, nullptr, nullptr, nullptr, nullptr, 1); }
            SEAM(pb + 0);
        }
        if (PHM(1) && IN(pb + 1)) { REFRESH();
            if ((IN8_MASK >> l) & 1) { REFRESH();
                pg8::Gemm g{Hb, (const bf16_t*)(F.ws + WS_WIN), DM / 2, DM / 2, DM / 2}; pg8::GridOrder S{MTOK / 256, NIN / 256, F.G, F.bid};
                pg8::EpiInProjT<true> E{Pb, U2, ropec, ropes, F.ws + WS_G8};
                pg8::gemm_phase(F.lds, F.tid, g, S, E);
            } else { REFRESH();
            pg8::Gemm g{Hb, (const bf16_t*)(F.ws + WS_WIN), DM, DM, DM}; pg8::GridOrder S{MTOK / 256, NIN / 256, F.G, F.bid};
            pg8::EpiInProj E{Pb, U2, ropec, ropes, F.ws + WS_G8};
            if (PRB(9)) { pg8::EpiBf16Plain E0{Pb, NIN, NIN / 256, nullptr}; pg8::gemm_phase(F.lds, F.tid, g, S, E0); REFRESH(); } pg8::gemm_phase(F.lds, F.tid, g, S, E); if (PRB(4)) { REFRESH(); pg8::gemm_phase(F.lds, F.tid, g, S, E); }
            }
            SEAM(pb + 1);
        }
        if (PHM(2) && IN(pb + 2)) { REFRESH();
            { pg8::Gemm g{U2, (const bf16_t*)(F.ws + WS_E), S5K, 512, 512}; pg8::S5StateOrder S{F.G, F.bid}; pg8::EpiS5State E{Sst}; pg8::gemm_phase(F.lds, F.tid, g, S, E); if (PRB(3)) { REFRESH(); pg8::gemm_phase(F.lds, F.tid, g, S, E); } }
            attn_phase(F, l);
            if (PRB(1)) attn_phase(F, l, 1);
            SEAM(pb + 2);
        }
        if (PHM(3) && IN(pb + 3)) { REFRESH(); scan_combine_phase(F); if (PRB(3)) scan_combine_phase(F); SEAM(pb + 3); }
        if (PHM(4) && IN(pb + 4)) { REFRESH();
            pg8::Gemm g{U2, (const bf16_t*)(F.ws + WS_TOEP), S5K, S5K, S5K}; pg8::S5MainOrder S{F.G, F.bid}; pg8::EpiS5Main E{U2, inptr(F, I_S5D) + l * 256, Gact};
            pg8::gemm_phase(F.lds, F.tid, g, S, E); if (PRB(3)) { REFRESH(); pg8::gemm_phase(F.lds, F.tid, g, S, E); }
            SEAM(pb + 4);
        }
        if (PHM(5) && IN(pb + 5)) { REFRESH();
            pg8::Gemm g{Gact, (const bf16_t*)(F.ws + WS_WGLU), 256, 256, 256}; pg8::GridOrderT<true> S{MTOK / 128, 1, F.G, F.bid}; pg8::EpiGLU E{Gact, inptr(F, I_BGLU) + l * 256, Ocat};
            pg8::gemm_phase(F.lds, F.tid, g, S, E); if (PRB(3)) { REFRESH(); pg8::gemm_phase(F.lds, F.tid, g, S, E); }
            SEAM(pb + 5);
        }
        if (PHM(6) && IN(pb + 6)) { REFRESH();
            pg8::Gemm g{Ocat, (const bf16_t*)(F.ws + WS_WBR), DM, DM, DM}; pg8::GridOrder S{MTOK / 256, DM / 256, F.G, F.bid}; pg8::EpiBranch E{F.ws + WS_G8, Merged};
            pg8::gemm_phase(F.lds, F.tid, g, S, E); if (PRB(5)) { REFRESH(); pg8::gemm_phase(F.lds, F.tid, g, S, E); }
            SEAM(pb + 6);
        }
        if (PHM(7) && IN(pb + 7)) { REFRESH();
            pg8::Gemm g{Merged, (const bf16_t*)(F.ws + WS_WOUT), DM, DM, DM}; pg8::GridOrder S{MTOK / 256, DM / 256, F.G, F.bid}; pg8::EpiBf16Plain E{Hb, DM, DM / 256, nullptr};
            pg8::gemm_phase(F.lds, F.tid, g, S, E); if (PRB(8)) { REFRESH(); pg8::gemm_phase(F.lds, F.tid, g, S, E); }
            SEAM(pb + 7);
        }
        if (PHM(8) && IN(pb + 8)) { REFRESH();
            for (int rep = 0; rep < 1 + PRB(0); ++rep) convert_ffn_weights(F, l);
            __syncthreads();
            norm_phase(F, l == 0 ? (const void*)inptr(F, I_X) : (const void*)Xb, l == 0 ? 0 : 1, Xb, Hb, 1, inptr(F, I_NORM_FFN) + l * DM, ((FP8_MASK >> l) & 1) ? Merged : Hb, nullptr,
                       moe ? inptr(F, I_ROUTER) + (size_t)(l >> 1) * DM * NEXP : nullptr, F.ctl + CW_MOECNT + 16 * (l >> 1), (int*)(F.ws + WS_BLKCNT) + (l >> 1) * 8192, 0, (FP8_MASK >> l) & 1);
            if (PRB(2)) norm_phase(F, Xb, 1, Xb, Hb, 1, inptr(F, I_NORM_FFN) + l * DM, Hb, nullptr, nullptr, nullptr, nullptr, 1);
            SEAM(pb + 8);
        }
        if (PHM(9) && IN(pb + 9) && moe) { REFRESH(); moe_finalize(F, (const int*)(F.ws + WS_BLKCNT) + (l >> 1) * 8192); SEAM(pb + 9); }
        if (PHM(10) && IN(pb + 10)) { REFRESH();
            load_moe_off(F, l);
            const int nT = F.moff[8] >> 8;
            if ((FP8_MASK >> l) & 1) { REFRESH();
#if FP8_FULL
                pg8::Gemm g{Merged, (const bf16_t*)(F.ws + WS_WGU), DM / 2, DM / 2, DM / 2}; pg8::FfnOrderT<true, false> S{nT, 2 * DFF / 256, F.G, F.bid, F.moff, (const int*)(F.ws + WS_TOKROW), moe ? 0 : 1};
                pg8::EpiSwiGLU8F E{F.ws + WS_HID, 2 * DFF / 256};
#else
                pg8::Gemm g{Merged, (const bf16_t*)(F.ws + WS_WGU), DM / 2, DM / 2, DM / 2}; pg8::FfnOrderT<true, true> S{2 * nT, 2 * DFF / 256, F.G, F.bid, F.moff, (const int*)(F.ws + WS_TOKROW), moe ? 0 : 1};
                pg8::EpiSwiGLU8 E{F.ws + WS_HID, 2 * DFF / 256};
#endif
                pg8::gemm_phase(F.lds, F.tid, g, S, E);
            } else { REFRESH();
            pg8::Gemm g{Hb, (const bf16_t*)(F.ws + WS_WGU), DM, DM, DM}; pg8::FfnOrderT<true> S{nT, 2 * DFF / 256, F.G, F.bid, F.moff, (const int*)(F.ws + WS_TOKROW), moe ? 0 : 1}; pg8::EpiSwiGLU E{Hid, 2 * DFF / 256};
            pg8::gemm_phase(F.lds, F.tid, g, S, E); if (PRB(6)) { REFRESH(); pg8::gemm_phase(F.lds, F.tid, g, S, E); }
            }
            SEAM(pb + 10);
        }
        if (PHM(11) && IN(pb + 11)) { REFRESH();
            load_moe_off(F, l);
            const int nT = F.moff[8] >> 8;
            if ((FP8_MASK >> l) & 1) { REFRESH();
#if FP8_FULL
                pg8::Gemm g{Hid, (const bf16_t*)(F.ws + WS_WD), DFF / 2, DFF / 2, DFF / 2}; pg8::FfnDownOrder S{F.G, F.bid, F.moff, pg8::DOWN_KSUB, DFF / 128};
                pg8::EpiBf16Plain8F E{Yb, DM, DM / 256, (bf16_t*)(F.ws + WS_YPART)};
#else
                pg8::Gemm g{Hid, (const bf16_t*)(F.ws + WS_WD), DFF / 2, DFF / 2, DFF / 2}; pg8::FfnDownOrderH S{F.G, F.bid, F.moff, pg8::DOWN_KSUB, DFF / 128};
                pg8::EpiBf16Plain8 E{Yb, DM, DM / 256, (bf16_t*)(F.ws + WS_YPART)};
#endif
                pg8::gemm_phase(F.lds, F.tid, g, S, E);
            } else { REFRESH();
            pg8::Gemm g{Hid, (const bf16_t*)(F.ws + WS_WD), DFF, DFF, DFF}; pg8::FfnDownOrder S{F.G, F.bid, F.moff, pg8::DOWN_KSUB * 2, DFF / 64}; pg8::EpiBf16Plain E{Yb, DM, DM / 256, (bf16_t*)(F.ws + WS_YPART)};
            pg8::gemm_phase(F.lds, F.tid, g, S, E); if (PRB(7)) { REFRESH(); pg8::gemm_phase(F.lds, F.tid, g, S, E); }
            }
            SEAM(pb + 11);
        }
        if (PHM(11) && IN(pb + 12) && moe) { REFRESH(); load_moe_off(F, l); splitk_reduce(F); SEAM(pb + 12); }
    }
    if (PHM(12) && IN(PPL * DEPTH)) { REFRESH(); load_moe_off(F, DEPTH - 1); norm_phase(F, Xb, 1, nullptr, Yb, ((DEPTH - 1) & 1) ? 2 : 1, inptr(F, I_NORM_FINAL), nullptr, args.out, nullptr, nullptr);
        if (PRB(2)) norm_phase(F, Xb, 1, nullptr, Yb, ((DEPTH - 1) & 1) ? 2 : 1, inptr(F, I_NORM_FINAL), nullptr, args.out, nullptr, nullptr, nullptr, 1); }
#undef IN
#undef SEAM
}

extern "C" void kernel_launch(void* const* d_in, const int* in_sizes, int n_in, void* d_out, int out_size, void* d_ws, size_t ws_size, hipStream_t stream) {
    static int grid = 0;
    if (grid == 0) {
        if (n_in != 27 || in_sizes[0] != MTOK * DM || out_size != MTOK * DM || ws_size < WS_END) { fprintf(stderr, "kernel_launch: unexpected shapes (n_in %d, in0 %d, out %d, ws %zu < %zu); nothing launched\n", n_in, n_in > 0 ? in_sizes[0] : -1, out_size, ws_size, (size_t)WS_END); grid = -1; return; }
        int dev = 0, cus = 0, per_cu = 0;
        if (hipGetDevice(&dev) != hipSuccess || hipDeviceGetAttribute(&cus, hipDeviceAttributeMultiprocessorCount, dev) != hipSuccess) { grid = -1; return; }
        if (hipFuncSetAttribute((const void*)trunk_fwd, hipFuncAttributeMaxDynamicSharedMemorySize, LDS_BYTES) != hipSuccess) { fprintf(stderr, "kernel_launch: hipFuncSetAttribute failed\n"); grid = -1; return; }
        if (hipOccupancyMaxActiveBlocksPerMultiprocessor(&per_cu, (const void*)trunk_fwd, NTHREADS, LDS_BYTES) != hipSuccess || per_cu < 1) { fprintf(stderr, "kernel_launch: occupancy query reports %d blocks per CU\n", per_cu); }
        (void)hipGetLastError();
        grid = cus;
    }
    if (grid < 0) return;
    if (hipMemsetAsync((char*)d_ws + WS_CTL, 0, CTL_ZERO_BYTES, stream) != hipSuccess) return;
    Args a{};
    for (int i = 0; i < 27; ++i) a.in[i] = (const float*)d_in[i];
    a.out = (float*)d_out; a.ws = (unsigned char*)d_ws;
#if MK_ONE_LAUNCH
    a.ph_lo = 0; a.ph_hi = NPH;
    hipLaunchKernelGGL(trunk_fwd, dim3(grid), dim3(NTHREADS), LDS_BYTES, stream, a);
#else
    for (int p = 0; p < NPH; ++p) {
        if (p < PPL * DEPTH && ((p % PPL) == 9 || (p % PPL) == 12) && ((p / PPL) & 1) == 0) continue;
        a.ph_lo = p; a.ph_hi = p + 1;
        hipLaunchKernelGGL(trunk_fwd, dim3(grid), dim3(NTHREADS), LDS_BYTES, stream, a);
    }
#endif
}
```

```cpp
#include <hip/hip_runtime.h>
#include <cstdio>
#include <cstdint>

#ifndef PROBE_DOUBLE
#define PROBE_DOUBLE 0
#endif
#define PRB(k) (((PROBE_DOUBLE) >> (k)) & 1)
#ifndef FP8_MASK
#define FP8_MASK 0xE
#endif
#ifndef MK_ONE_LAUNCH
#define MK_ONE_LAUNCH 1
#endif

#ifndef IN8_MASK
#define IN8_MASK 0xF
#endif
#ifndef FP8_FULL
#define FP8_FULL 1
#endif
#ifndef PH_MASK
#define PH_MASK 0x1FFF
#endif
#define PHM(k) (((PH_MASK) >> (k)) & 1)
#define LAS __attribute__((address_space(3)))
#define GAS __attribute__((address_space(1)))
typedef unsigned short bf16_t;
typedef short bf16x8 __attribute__((ext_vector_type(8)));
typedef short s16x4 __attribute__((ext_vector_type(4)));
typedef short v4i16_t __attribute__((ext_vector_type(4)));
typedef float f32x2 __attribute__((ext_vector_type(2)));
typedef float f32x4 __attribute__((ext_vector_type(4)));
typedef float f32x16 __attribute__((ext_vector_type(16)));
typedef unsigned u32x2 __attribute__((ext_vector_type(2)));
typedef unsigned u32x4 __attribute__((ext_vector_type(4)));
typedef __bf16 bf16x2_t __attribute__((ext_vector_type(2)));
typedef int v4i32 __attribute__((ext_vector_type(4)));
typedef int v8i32 __attribute__((ext_vector_type(8)));

constexpr int BATCH = 16, SEQ = 2048, DM = 1024, MTOK = BATCH * SEQ, DEPTH = 4;
constexpr int NIN = 6400, DFF = 3584, NEXP = 8;
constexpr int C_QA = 0, C_KA = 768, C_VA = 1536, C_U = 2304, C_QC = 2560, C_KC = 3072, C_VC = 3200, C_G = 3328;
constexpr int S5T = 32, S5NC = SEQ / S5T, S5ROWS = BATCH * S5NC, S5K = 640;
constexpr int MOE_ROWS = 67584;
constexpr float RMS_EPS = 1e-6f;
constexpr int NWAVES = 8, NTHREADS = 512;
constexpr int PPL = 13, NPH = PPL * DEPTH + 1;

constexpr size_t MiB = 1u << 20;
constexpr size_t WS_CTL = 0, CTL_ZERO_BYTES = 1 * MiB;
constexpr size_t WS_ROPE = 1 * MiB;
constexpr size_t WS_AT = 1 * MiB + 512 * 1024;
constexpr size_t WS_TOKE = 2 * MiB, WS_TOKP = 2 * MiB + 256 * 1024, WS_TOKW = 2 * MiB + 512 * 1024;
constexpr size_t WS_LSE = 3 * MiB;
constexpr size_t WS_TOKROW = 5 * MiB;
constexpr size_t WS_BLKCNT = 6 * MiB;
constexpr size_t WS_WIN = 8 * MiB, WS_WBR = 21 * MiB, WS_WOUT = 23 * MiB, WS_WGLU = 25 * MiB, WS_TOEP = 26 * MiB, WS_E = 36 * MiB, WS_WGU = 40 * MiB, WS_WD = 96 * MiB, WS_XB = 124 * MiB;
constexpr size_t WS_H = 208 * MiB;
constexpr size_t WS_PROJ = 272 * MiB, WS_OCAT = 672 * MiB, WS_MERGED = 736 * MiB, WS_U2 = 800 * MiB, WS_SST = 820 * MiB, WS_GACT = 828 * MiB;
constexpr size_t WS_HID = 272 * MiB, WS_Y = 734 * MiB, WS_YPART = 866 * MiB, WS_G8 = 890 * MiB, WS_END = 986 * MiB;
static_assert(WS_WIN + (size_t)NIN * DM * 2 <= WS_WBR && WS_TOEP + (size_t)16 * 512 * S5K * 2 <= WS_E && WS_E + (size_t)16 * 256 * 512 * 2 <= WS_WGU, "ws map 1");
static_assert((FP8_MASK & 0xA) == 0xA, "the ws map holds the MoE FFN weights as fp8 bytes");
static_assert(WS_WGU + (size_t)NEXP * 2 * DFF * DM <= WS_WD && WS_WGU + (size_t)2 * DFF * DM * 2 <= WS_WD && WS_WD + (size_t)NEXP * DM * DFF <= WS_XB && WS_WD + (size_t)DM * DFF * 2 <= WS_XB && WS_XB + (size_t)MTOK * DM * 2 <= WS_H && WS_H + (size_t)MTOK * DM * 2 <= WS_PROJ, "ws map 2");
static_assert(WS_PROJ + (size_t)MTOK * NIN * 2 <= WS_OCAT && WS_U2 + (size_t)16 * S5ROWS * S5K * 2 <= WS_SST && WS_SST + (size_t)16 * S5ROWS * 128 * 4 <= WS_GACT && WS_GACT + (size_t)MTOK * 256 * 2 <= WS_END, "ws map 3");
static_assert(WS_HID + (size_t)MOE_ROWS * DFF * 2 <= WS_Y && WS_Y + (size_t)MOE_ROWS * DM * 2 <= WS_YPART && WS_YPART + (size_t)6 * 2048 * DM * 2 <= WS_G8 && WS_G8 + (size_t)MTOK * 3 * DM <= WS_END, "ws map 4");
constexpr int CW_TMO = 0, CW_MOECNT = 64, CW_BAR = 4096;

constexpr int RING_BYTES = 131072;
constexpr int LDSCTL_OFF = RING_BYTES;
constexpr int LDS_BYTES = 147456;

__device__ __forceinline__ unsigned cvt_pk_bf16(float lo, float hi) { f32x2 v = {lo, hi}; bf16x2_t b = __builtin_convertvector(v, bf16x2_t); return __builtin_bit_cast(unsigned, b); }
__device__ __forceinline__ float bf_lo(unsigned w) { return __uint_as_float(w << 16); }
__device__ __forceinline__ float bf_hi(unsigned w) { return __uint_as_float(w & 0xffff0000u); }
__device__ __forceinline__ u32x4 pack8(const f32x4 a, const f32x4 b) { u32x4 w; w.x = cvt_pk_bf16(a[0], a[1]); w.y = cvt_pk_bf16(a[2], a[3]); w.z = cvt_pk_bf16(b[0], b[1]); w.w = cvt_pk_bf16(b[2], b[3]); return w; }
__device__ __forceinline__ void unpack8(const u32x4 w, f32x4& a, f32x4& b) { a = (f32x4){bf_lo(w.x), bf_hi(w.x), bf_lo(w.y), bf_hi(w.y)}; b = (f32x4){bf_lo(w.z), bf_hi(w.z), bf_lo(w.w), bf_hi(w.w)}; }
__device__ __forceinline__ unsigned pack4_gate(float a, float b, float c, float d) {
    const unsigned w0 = __builtin_bit_cast(unsigned, __builtin_amdgcn_cvt_pknorm_u16(a, b)), w1 = __builtin_bit_cast(unsigned, __builtin_amdgcn_cvt_pknorm_u16(c, d));
    return __builtin_amdgcn_perm(w1, w0, 0x07050301u) | 0x01010101u; }
__device__ __forceinline__ u32x2 pack8_gate(const f32x4 a, const f32x4 b) { u32x2 o; o.x = pack4_gate(a[0], a[1], a[2], a[3]); o.y = pack4_gate(b[0], b[1], b[2], b[3]); return o; }
__device__ __forceinline__ u32x2 pack8_u8(const f32x4 a, const f32x4 b) {
    unsigned q[8];
#pragma unroll
    for (int j = 0; j < 4; ++j) { q[j] = (unsigned)(a[j] + 0.5f); q[4 + j] = (unsigned)(b[j] + 0.5f); }
    u32x2 o; o.x = q[0] | (q[1] << 8) | (q[2] << 16) | (q[3] << 24); o.y = q[4] | (q[5] << 8) | (q[6] << 16) | (q[7] << 24); return o; }
__device__ __forceinline__ void unpack8_u8(const u32x2 w, f32x4& a, f32x4& b) {
    a = (f32x4){(float)(w.x & 255u), (float)((w.x >> 8) & 255u), (float)((w.x >> 16) & 255u), (float)(w.x >> 24)};
    b = (f32x4){(float)(w.y & 255u), (float)((w.y >> 8) & 255u), (float)((w.y >> 16) & 255u), (float)(w.y >> 24)}; }
__device__ __forceinline__ void unpack8_fp8(const u32x2 w, f32x4& a, f32x4& b) {
    const auto a0 = __builtin_amdgcn_cvt_pk_f32_fp8((int)w.x, false), a1 = __builtin_amdgcn_cvt_pk_f32_fp8((int)w.x, true), b0 = __builtin_amdgcn_cvt_pk_f32_fp8((int)w.y, false), b1 = __builtin_amdgcn_cvt_pk_f32_fp8((int)w.y, true);
    a = (f32x4){a0[0], a0[1], a1[0], a1[1]}; b = (f32x4){b0[0], b0[1], b1[0], b1[1]}; }
__device__ __forceinline__ void swap32(unsigned& a, unsigned& b) { const auto r = __builtin_amdgcn_permlane32_swap(a, b, false, false); a = r[0]; b = r[1]; }
__device__ __forceinline__ void swap16(unsigned& a, unsigned& b) { const auto r = __builtin_amdgcn_permlane16_swap(a, b, false, false); a = r[0]; b = r[1]; }
__device__ __forceinline__ u32x2 pack8_fp8(const f32x4 a, const f32x4 b) {
    f32x4 x = a, y = b;
#pragma unroll
    for (int j = 0; j < 4; ++j) { x[j] = __builtin_amdgcn_fmed3f(x[j], -448.0f, 448.0f); y[j] = __builtin_amdgcn_fmed3f(y[j], -448.0f, 448.0f); }
    int w0 = __builtin_amdgcn_cvt_pk_fp8_f32(x[0], x[1], 0, false); w0 = __builtin_amdgcn_cvt_pk_fp8_f32(x[2], x[3], w0, true);
    int w1 = __builtin_amdgcn_cvt_pk_fp8_f32(y[0], y[1], 0, false); w1 = __builtin_amdgcn_cvt_pk_fp8_f32(y[2], y[3], w1, true);
    u32x2 o; o.x = (unsigned)w0; o.y = (unsigned)w1; return o;
}
__device__ __forceinline__ float sigmoid_f(float x) { return __builtin_amdgcn_rcpf(1.0f + __expf(-x)); }
__device__ __forceinline__ float gelu_tanh_f(float x) { const float z = 0.7978845608f * (x + 0.044715f * x * x * x); const float t = 1.0f - 2.0f * __builtin_amdgcn_rcpf(1.0f + __expf(2.0f * z)); return 0.5f * x * (1.0f + t); }
__device__ __forceinline__ float shfl_xor_l(float v, int mask, int lane) { return __int_as_float(__builtin_amdgcn_ds_bpermute((lane ^ mask) << 2, __float_as_int(v))); }
#define LDS_WAIT() asm volatile("s_waitcnt lgkmcnt(0)" ::: "memory")

namespace pg8 {
#ifndef PG8_WGM
#define PG8_WGM 4
#endif
constexpr int BM = 256, BK = 64, HALF = 128, HTB = HALF * BK * 2, STAGE_BYTES = 8 * HTB, NXCD = 8, WGM = PG8_WGM;
__host__ __device__ __forceinline__ int lds_byte(int r, int c) { const int st = (r >> 4) * 2 + (c >> 5), rr = r & 15, cc = c & 31, ob = rr * 64 + cc * 2; return st * 1024 + (ob ^ (((ob >> 9) & 1) << 5)); }
__host__ __device__ __forceinline__ void stage_rc(int b, int& R, int& C) { const int st = b / 1024, sb = b % 1024, swz = sb ^ (((sb >> 9) & 1) << 5); R = (st >> 1) * 16 + swz / 64; C = (st & 1) * 32 + (swz % 64) / 2; }
__host__ __device__ __forceinline__ int perm32(int rho) { const int n = rho >> 4, i = rho & 15; return 8 * (i >> 2) + 4 * n + (i & 3); }

struct Unit { int pm, pn, koff = 0, nt = 0, ks = 0, pi = 0; };
struct Gemm { const bf16_t* A; const bf16_t* Bt; int lda, ldb, K; };

__device__ __forceinline__ void tile_order(int L, int nM, int nN, int& pm, int& pn) {
    const int nwg = nM * nN; int wgid = L; { const int q = nwg / NXCD, r = nwg % NXCD, xcd = wgid % NXCD, off = wgid / NXCD; wgid = (xcd < r ? xcd * (q + 1) : r * (q + 1) + (xcd - r) * q) + off; }
    const int nig = WGM * nN, gid = wgid / nig, fm = gid * WGM, gsz = (nM - fm) < WGM ? (nM - fm) : WGM;
    pm = fm + ((wgid % nig) % gsz); pn = (wgid % nig) / gsz;
}
template <bool HM> struct GridOrderT { static constexpr bool GATHER = false, SPLITK = false, HALFM = HM; int nM, nN, G, c;
    __device__ __forceinline__ bool next(int i, Unit& u) const { const int L = i * G + c; if (L >= nM * nN) return false; tile_order(L, nM, nN, u.pm, u.pn); return true; } };
using GridOrder = GridOrderT<false>;
struct S5StateOrder { static constexpr bool GATHER = false, SPLITK = false, HALFM = true; int G, c;
    __device__ __forceinline__ bool next(int i, Unit& u) const { const int L = i * G + c; if (L >= 128) return false; u.pm = L; u.pn = L >> 3; return true; } };
struct S5MainOrder { static constexpr bool GATHER = false, SPLITK = false, HALFM = true; int G, c;
    __device__ __forceinline__ bool next(int i, Unit& u) const { const int L = i * G + c; if (L >= 256) return false; const int g = L >> 4, r = L & 15; u.pm = g * 8 + (r & 7); u.pn = g * 2 + (r >> 3); return true; } };
template <bool GATHER_, bool HALFM_ = false> struct FfnOrderT { static constexpr bool GATHER = GATHER_, SPLITK = false, HALFM = HALFM_; static constexpr int RT = HALFM_ ? 128 : 256; int nT, nN, G, c; const LAS int* off; const int* tokrow; int dense;
    __device__ __forceinline__ bool next(int i, Unit& u) const { const int L = i * G + c; if (L >= nT * nN) return false; int pm, pnl; tile_order(L, nT, nN, pm, pnl);
        int e = 0;
#pragma unroll
        for (int k = 1; k < 8; ++k) e += (off[k] <= pm * RT) ? 1 : 0;
        u.pm = pm; u.pn = e * nN + pnl; return true; }
    __device__ __forceinline__ int tok(const Unit& u, int trow) const { const int sr = u.pm * RT + (trow & (RT - 1)); if (dense) return sr; const int e = u.pn / nN, pos = sr - off[e];
        return (pos < off[16 + e]) ? tokrow[(size_t)e * MTOK + pos] : 0; } };
constexpr int DOWN_SPL = 7, DOWN_KSUB = DFF / DOWN_SPL;
struct FfnDownOrder { static constexpr bool GATHER = false, SPLITK = true, HALFM = false; int G, c; const LAS int* mo; int slice_b, full_nt;
    __device__ __forceinline__ bool next(int i, Unit& u) const { const int L = i * G + c; const int nFull = mo[32], np = mo[33]; if (L >= nFull * 4 + np * 4 * DOWN_SPL) return false;
        if (L < nFull * 4) { int fi, pnl; tile_order(L, nFull, 4, fi, pnl); int e = 0;
#pragma unroll
            for (int k = 1; k < 8; ++k) e += (mo[24 + k] <= fi) ? 1 : 0;
            u.pm = (mo[e] >> 8) + (fi - mo[24 + e]); u.pn = e * 4 + pnl; u.koff = 0; u.nt = full_nt; u.ks = 0; u.pi = 0; }
        else { const int j = (int)(L - nFull * 4), ks = j % DOWN_SPL, rest = j / DOWN_SPL, pnl = rest & 3, pi = rest >> 2, e = mo[40 + pi];
            u.pm = (mo[e] >> 8) + (mo[16 + e] >> 8); u.pn = e * 4 + pnl; u.koff = ks * slice_b; u.nt = slice_b / (BK * 2); u.ks = ks; u.pi = pi; }
        return true; } };

struct FfnDownOrderH { static constexpr bool GATHER = false, SPLITK = true, HALFM = true; int G, c; const LAS int* mo; int slice_b, full_nt;
    __device__ __forceinline__ bool next(int i, Unit& u) const { const int L = i * G + c; const int nFullH = 2 * mo[32], npH = 2 * mo[33]; if (L >= nFullH * 4 + npH * 4 * DOWN_SPL) return false;
        if (L < nFullH * 4) { int fh, pnl; tile_order(L, nFullH, 4, fh, pnl); const int fi = fh >> 1; int e = 0;
#pragma unroll
            for (int k = 1; k < 8; ++k) e += (mo[24 + k] <= fi) ? 1 : 0;
            u.pm = ((mo[e] >> 8) + (fi - mo[24 + e])) * 2 + (fh & 1); u.pn = e * 4 + pnl; u.koff = 0; u.nt = full_nt; u.ks = 0; u.pi = 0; }
        else { const int j = (int)(L - nFullH * 4), ks = j % DOWN_SPL, rest = j / DOWN_SPL, pnl = rest & 3, ph = rest >> 2, e = mo[40 + (ph >> 1)];
            u.pm = ((mo[e] >> 8) + (mo[16 + e] >> 8)) * 2 + (ph & 1); u.pn = e * 4 + pnl; u.koff = ks * slice_b; u.nt = slice_b / (BK * 2); u.ks = ks; u.pi = ph; }
        return true; } };

template <class Epi, class Sched>
__device__ __forceinline__ void gemm_phase(LAS unsigned char* lds, const int tid, const Gemm g, const Sched& S, const Epi& E) {
    const int wid = __builtin_amdgcn_readfirstlane(tid >> 6), lane = tid & 63, wr = wid >> 2, wc = wid & 3, fr = lane & 15, fq = lane >> 4;
    const int K = g.K, nt = K / BK;
    unsigned voffA[2], voffB[2];
#pragma unroll
    for (int i = 0; i < 2; ++i) { int R, C; stage_rc(tid * 16 + i * 8192, R, C); const int Rb = Epi::PERM ? ((R & ~31) + perm32(R & 31)) : R;
        voffA[i] = (unsigned)(R * g.lda + C) * 2u; voffB[i] = (unsigned)(Rb * g.ldb + C) * 2u; }
    const size_t kstep = (size_t)(BK * 2);
    const size_t hstepA = (size_t)HALF * g.lda * 2, hstepB = (size_t)HALF * g.ldb * 2;
    static_assert(Epi::HALFM == Sched::HALFM, "half-tile epilogue and order go together");
    const size_t tstepA = Sched::GATHER ? 0 : (Sched::HALFM ? hstepA : 2 * hstepA), tstepB = 2 * hstepB;
    int gR[2], gC[2];
#pragma unroll
    for (int i = 0; i < 2; ++i) stage_rc(tid * 16 + i * 8192, gR[i], gC[i]);
    unsigned vA0[2], vA1[2], vN0[2], vN1[2];
#define PG8_GOFF(U, d0, d1) do { _Pragma("unroll") for (int _i = 0; _i < 2; ++_i) { \
        d0[_i] = (unsigned)((size_t)S.tok(U, gR[_i]) * g.lda + gC[_i]) * 2u; d1[_i] = (unsigned)((size_t)S.tok(U, HALF + gR[_i]) * g.lda + gC[_i]) * 2u; } } while (0)
#define PG8_STAGE_A(bufoff, base, half, v0, v1) do { if constexpr (Sched::GATHER) { if (half) PG8_STAGE(bufoff, base, v1); else PG8_STAGE(bufoff, base, v0); } \
        else { PG8_STAGE(bufoff, (base) + (half) * hstepA, voffA); } } while (0)
    const unsigned ldsw = (unsigned)wid * 1024u;
    const int aoff = lds_byte(wr * 64 + fr, fq * 8), boff = lds_byte(wc * 32 + fr, fq * 8);
#define PG8_SA(b, h) (((b) * 2 + (h)) * HTB)
#define PG8_SB(b, h) ((4 + (b) * 2 + (h)) * HTB)
#define PG8_STAGE(bufoff, gbase, voff) do { _Pragma("unroll") for (int _i = 0; _i < 2; ++_i) \
        __builtin_amdgcn_global_load_lds((const unsigned*)((const char*)(gbase) + (voff)[_i]), (LAS unsigned*)(lds + (bufoff) + ldsw + _i * 8192), 16, 0, 0); } while (0)
#define PG8_LDA(dst, b, h) do { _Pragma("unroll") for (int m = 0; m < 4; ++m) _Pragma("unroll") for (int k = 0; k < 2; ++k) dst[m][k] = *(const LAS bf16x8*)(lds + PG8_SA(b, h) + aoff + m * 2048 + k * 1024); } while (0)
#define PG8_LDB(dst, b, h) do { _Pragma("unroll") for (int n = 0; n < 2; ++n) _Pragma("unroll") for (int k = 0; k < 2; ++k) dst[n][k] = *(const LAS bf16x8*)(lds + PG8_SB(b, h) + boff + n * 2048 + k * 1024); } while (0)
#define PG8_MMA(ai, bj, At, Bt) do { __builtin_amdgcn_s_setprio(1); \
        if constexpr (Epi::FP8) { _Pragma("unroll") for (int m = 0; m < 4; ++m) _Pragma("unroll") for (int n = 0; n < 2; ++n) \
            asm volatile("v_mfma_scale_f32_16x16x128_f8f6f4 %0, %1, %2, %0, %3, %3 op_sel_hi:[0,0,0]" : "+v"(acc[ai][bj][m][n]) : "v"(__builtin_shufflevector(__builtin_bit_cast(v4i32, Bt[n][0]), __builtin_bit_cast(v4i32, Bt[n][1]), 0, 1, 2, 3, 4, 5, 6, 7)), \
                "v"(__builtin_shufflevector(__builtin_bit_cast(v4i32, At[m][0]), __builtin_bit_cast(v4i32, At[m][1]), 0, 1, 2, 3, 4, 5, 6, 7)), "v"(0x7f7f7f7f)); } \
        else { _Pragma("unroll") for (int m = 0; m < 4; ++m) _Pragma("unroll") for (int n = 0; n < 2; ++n) _Pragma("unroll") for (int k = 0; k < 2; ++k) \
            acc[ai][bj][m][n] = __builtin_amdgcn_mfma_f32_16x16x32_bf16(Bt[n][k], At[m][k], acc[ai][bj][m][n], 0, 0, 0); } \
        __builtin_amdgcn_s_setprio(0); } while (0)
#define PG8_WAIT_V(n) asm volatile("s_waitcnt vmcnt(" #n ")" ::: "memory")
#define PG8_WAIT_L(n) asm volatile("s_waitcnt lgkmcnt(" #n ")" ::: "memory")
#define PG8_BAR __builtin_amdgcn_s_barrier()
#define PG8_SCHED __builtin_amdgcn_sched_barrier(0)
    Unit cur, nxt; int ui = 0;
    if (!S.next(0, cur)) return;
    f32x4 acc[2][2][4][2];
#pragma unroll
    for (int a = 0; a < 2; ++a)
#pragma unroll
        for (int b = 0; b < 2; ++b)
#pragma unroll
            for (int m = 0; m < 4; ++m)
#pragma unroll
                for (int n = 0; n < 2; ++n) acc[a][b][m][n] = (f32x4){0.f, 0.f, 0.f, 0.f};
    bf16x8 At[4][2], B0[2][2], B1[2][2];
    const char* cA = (const char*)g.A + (size_t)cur.pm * tstepA; const char* cB = (const char*)g.Bt + (size_t)cur.pn * tstepB;
    if constexpr (Sched::SPLITK) { cA += cur.koff; cB += cur.koff; }
    if constexpr (Sched::GATHER) { PG8_GOFF(cur, vA0, vA1); }
    PG8_STAGE(PG8_SB(0, 0), cB, voffB); PG8_STAGE(PG8_SB(0, 1), cB + hstepB, voffB); PG8_STAGE_A(PG8_SA(0, 0), cA, 0, vA0, vA1); if constexpr (!Epi::HALFM) { PG8_STAGE_A(PG8_SA(0, 1), cA, 1, vA0, vA1); }
    if (wr == 1) PG8_BAR;
    if constexpr (Epi::HALFM) { PG8_WAIT_V(0); } else { PG8_WAIT_V(2); } PG8_BAR;
    PG8_STAGE(PG8_SB(1, 0), cB + kstep, voffB); PG8_STAGE_A(PG8_SA(1, 0), cA + kstep, 0, vA0, vA1); PG8_STAGE(PG8_SB(1, 1), cB + hstepB + kstep, voffB);
    PG8_WAIT_V(6); PG8_BAR;
    for (;;) {
        const bool has_next = S.next(ui + 1, nxt);
        const char* nA = has_next ? (const char*)g.A + (size_t)nxt.pm * tstepA : cA; const char* nB = has_next ? (const char*)g.Bt + (size_t)nxt.pn * tstepB : cB;
        if constexpr (Sched::SPLITK) { if (has_next) { nA += nxt.koff; nB += nxt.koff; } }
        const int unt = Sched::SPLITK ? cur.nt : nt;
        if constexpr (Sched::GATHER) { if (has_next) { PG8_GOFF(nxt, vN0, vN1); } else {
#pragma unroll
            for (int _i = 0; _i < 2; ++_i) { vN0[_i] = vA0[_i]; vN1[_i] = vA1[_i]; } } }
#pragma unroll 1
        for (int t = 0; t < unt; t += 2) {
            const bool last = (t == unt - 2);
            const char* a1 = cA + (size_t)(t + 1) * kstep;
            const char* a2 = last ? nA : cA + (size_t)(t + 2) * kstep; const char* b2 = last ? nB : cB + (size_t)(t + 2) * kstep;
            const char* a3 = a2 + kstep; const char* b3 = b2 + kstep;
            unsigned s0[2], s1[2];
            if constexpr (Sched::GATHER) {
#pragma unroll
                for (int _i = 0; _i < 2; ++_i) { s0[_i] = last ? vN0[_i] : vA0[_i]; s1[_i] = last ? vN1[_i] : vA1[_i]; } }
            PG8_LDB(B0, 0, 0); PG8_LDB(B1, 0, 1); PG8_SCHED; PG8_LDA(At, 0, 0); if constexpr (!Epi::HALFM) { PG8_STAGE_A(PG8_SA(1, 1), a1, 1, vA0, vA1); }
            PG8_WAIT_V(8); PG8_WAIT_L(0); PG8_BAR; PG8_MMA(0, 0, At, B0); if constexpr (!Epi::HALFM) { PG8_MMA(0, 1, At, B1); } PG8_BAR; PG8_SCHED;
            if constexpr (!Epi::HALFM) { PG8_LDA(At, 0, 1); } PG8_STAGE(PG8_SB(0, 0), b2, voffB); PG8_STAGE(PG8_SB(0, 1), b2 + hstepB, voffB); PG8_STAGE_A(PG8_SA(0, 0), a2, 0, s0, s1);
            if constexpr (Epi::HALFM) { PG8_WAIT_V(6); } else { PG8_WAIT_V(8); } PG8_WAIT_L(0); PG8_BAR; if constexpr (!Epi::HALFM) { PG8_MMA(1, 0, At, B0); PG8_MMA(1, 1, At, B1); } else { PG8_MMA(0, 1, At, B1); } PG8_BAR; PG8_SCHED;
            PG8_LDB(B0, 1, 0); PG8_LDB(B1, 1, 1); PG8_SCHED; PG8_LDA(At, 1, 0); if constexpr (!Epi::HALFM) { PG8_STAGE_A(PG8_SA(0, 1), a2, 1, s0, s1); }
            PG8_WAIT_V(8); PG8_WAIT_L(0); PG8_BAR; PG8_MMA(0, 0, At, B0); if constexpr (!Epi::HALFM) { PG8_MMA(0, 1, At, B1); } PG8_BAR; PG8_SCHED;
            if constexpr (!Epi::HALFM) { PG8_LDA(At, 1, 1); } PG8_STAGE(PG8_SB(1, 0), b3, voffB); PG8_STAGE(PG8_SB(1, 1), b3 + hstepB, voffB); PG8_STAGE_A(PG8_SA(1, 0), a3, 0, s0, s1);
            if constexpr (Epi::HALFM) { PG8_WAIT_V(6); } else { PG8_WAIT_V(8); } PG8_WAIT_L(0); PG8_BAR; if constexpr (!Epi::HALFM) { PG8_MMA(1, 0, At, B0); PG8_MMA(1, 1, At, B1); } else { PG8_MMA(0, 1, At, B1); } PG8_BAR; PG8_SCHED;
            if constexpr (Epi::HAS_MID) { if (t + 2 == Epi::MID1 || t + 2 == Epi::MID2) E.mid(acc, cur, wr, wc, fr, fq, (t + 2 == Epi::MID2) ? 1 : 0); }
        }
        if (wr == 0) PG8_BAR;
        E(acc, cur, wr, wc, fr, fq);
        if (!has_next) break;
#pragma unroll
        for (int a = 0; a < 2; ++a)
#pragma unroll
            for (int b = 0; b < 2; ++b)
#pragma unroll
                for (int m = 0; m < 4; ++m)
#pragma unroll
                    for (int n = 0; n < 2; ++n) acc[a][b][m][n] = (f32x4){0.f, 0.f, 0.f, 0.f};
        cur = nxt; cA = nA; cB = nB; ++ui;
        if constexpr (Sched::GATHER) {
#pragma unroll
            for (int _i = 0; _i < 2; ++_i) { vA0[_i] = vN0[_i]; vA1[_i] = vN1[_i]; } }
        if (wr == 1) PG8_BAR;
    }
    PG8_WAIT_V(0);
    PG8_BAR;
#undef PG8_GOFF
#undef PG8_STAGE_A
#undef PG8_SA
#undef PG8_SB
#undef PG8_STAGE
#undef PG8_LDA
#undef PG8_LDB
#undef PG8_MMA
#undef PG8_WAIT_V
#undef PG8_WAIT_L
#undef PG8_BAR
#undef PG8_SCHED
}

struct EpiBf16Plain {
    static constexpr bool PERM = true, HAS_MID = false, FP8 = false, HALFM = false; static constexpr int MID1 = -1, MID2 = -1;
    bf16_t* O; int ldc; int nNl; bf16_t* part;
    __device__ __forceinline__ void operator()(const f32x4 (&acc)[2][2][4][2], const Unit& u, int wr, int wc, int fr_in, int fq) const {
        int fr = fr_in; asm volatile("" : "+v"(fr));
        const int rt0 = wr * 64 + fr, col0 = (u.pn % nNl) * BM + wc * 32 + 8 * fq;
        bf16_t* base = (u.ks == 0) ? O + (size_t)(u.pm * BM + rt0) * ldc : part + (size_t)((u.ks - 1) * 2048 + u.pi * 256 + rt0) * ldc;
#pragma unroll
        for (int ai = 0; ai < 2; ++ai)
#pragma unroll
            for (int m = 0; m < 4; ++m) { bf16_t* rowp = base + (size_t)(ai * HALF + m * 16) * ldc + col0;
#pragma unroll
                for (int bj = 0; bj < 2; ++bj) *(u32x4*)(rowp + bj * HALF) = pack8(acc[ai][bj][m][0], acc[ai][bj][m][1]); }
    }
};
struct EpiSwiGLU {
    static constexpr bool PERM = true, HAS_MID = false, FP8 = false, HALFM = false; static constexpr int MID1 = -1, MID2 = -1;
    bf16_t* Hd; int nNl;
    __device__ __forceinline__ void operator()(const f32x4 (&acc)[2][2][4][2], const Unit& u, int wr, int wc, int fr_in, int fq) const {
        int fr = fr_in; asm volatile("" : "+v"(fr));
        const int row0 = u.pm * BM + wr * 64 + fr, col0 = (u.pn % nNl) * HALF + wc * 32 + 8 * fq;
#pragma unroll
        for (int ai = 0; ai < 2; ++ai)
#pragma unroll
            for (int m = 0; m < 4; ++m) { f32x4 o[2];
#pragma unroll
                for (int n = 0; n < 2; ++n)
#pragma unroll
                    for (int j = 0; j < 4; ++j) { const float gt = acc[ai][0][m][n][j], up = acc[ai][1][m][n][j]; o[n][j] = gt * sigmoid_f(gt) * up; }
                *(u32x4*)(Hd + (size_t)(row0 + ai * HALF + m * 16) * DFF + col0) = pack8(o[0], o[1]); }
    }
};
struct EpiSwiGLU8 {
    static constexpr bool PERM = true, HAS_MID = false, FP8 = true, HALFM = true; static constexpr int MID1 = -1, MID2 = -1;
    unsigned char* Hd; int nNl;
    __device__ __forceinline__ void operator()(const f32x4 (&acc)[2][2][4][2], const Unit& u, int wr, int wc, int fr_in, int fq) const {
        int fr = fr_in; asm volatile("" : "+v"(fr)); asm volatile("s_nop 15\n\ts_nop 15\n\ts_nop 15" ::: "memory");
        const int row0 = u.pm * HALF + wr * 64 + fr, col0 = (u.pn % nNl) * HALF + wc * 32 + 8 * fq;
#pragma unroll
        for (int m = 0; m < 4; ++m) { f32x4 o[2];
#pragma unroll
            for (int n = 0; n < 2; ++n)
#pragma unroll
                for (int j = 0; j < 4; ++j) { const float gt = acc[0][0][m][n][j] * 0.001953125f, up = acc[0][1][m][n][j] * 0.001953125f; o[n][j] = gt * sigmoid_f(gt) * up * 8.0f; }
            *(u32x2*)(Hd + (size_t)(row0 + m * 16) * DFF + col0) = pack8_fp8(o[0], o[1]); }
    }
};
struct EpiSwiGLU8F {
    static constexpr bool PERM = true, HAS_MID = false, FP8 = true, HALFM = false; static constexpr int MID1 = -1, MID2 = -1;
    unsigned char* Hd; int nNl;
    __device__ __forceinline__ void operator()(const f32x4 (&acc)[2][2][4][2], const Unit& u, int wr, int wc, int fr_in, int fq) const {
        int fr = fr_in; asm volatile("" : "+v"(fr)); asm volatile("s_nop 15\n\ts_nop 15\n\ts_nop 15" ::: "memory");
        const int row0 = u.pm * BM + wr * 64 + fr, col0 = (u.pn % nNl) * HALF + wc * 32 + 8 * fq;
#pragma unroll
        for (int ai = 0; ai < 2; ++ai)
#pragma unroll
        for (int mp = 0; mp < 2; ++mp) { u32x2 w[2];
#pragma unroll
          for (int mm = 0; mm < 2; ++mm) { const int m = 2 * mp + mm; f32x4 o[2];
#pragma unroll
            for (int n = 0; n < 2; ++n)
#pragma unroll
                for (int j = 0; j < 4; ++j) { const float ag = acc[ai][0][m][n][j], au = acc[ai][1][m][n][j];
                    const float t = __builtin_amdgcn_exp2f(ag * (-0.001953125f * 1.4426950408889634f)); o[n][j] = (ag * au) * __builtin_amdgcn_rcpf(__builtin_fmaf(t, 32768.0f, 32768.0f)); }
            w[mm] = pack8_fp8(o[0], o[1]); }
          unsigned a0 = w[0].x, a1 = w[0].y, b0 = w[1].x, b1 = w[1].y; swap16(a0, b0); swap16(a1, b1);
          *(u32x4*)(Hd + (size_t)(row0 + ai * HALF + (2 * mp + (fq & 1)) * 16) * DFF + (col0 - 8 * (fq & 1))) = (u32x4){a0, a1, b0, b1}; }
    }
};
struct EpiBf16Plain8F {
    static constexpr bool PERM = true, HAS_MID = false, FP8 = true, HALFM = false; static constexpr int MID1 = -1, MID2 = -1;
    bf16_t* O; int ldc; int nNl; bf16_t* part;
    __device__ __forceinline__ void operator()(const f32x4 (&acc)[2][2][4][2], const Unit& u, int wr, int wc, int fr_in, int fq) const {
        int fr = fr_in; asm volatile("" : "+v"(fr)); asm volatile("s_nop 15\n\ts_nop 15\n\ts_nop 15" ::: "memory");
        const int rt0 = wr * 64 + fr, col0 = (u.pn % nNl) * BM + wc * 32 + 8 * fq;
        bf16_t* base = (u.ks == 0) ? O + (size_t)(u.pm * BM + rt0) * ldc : part + (size_t)((u.ks - 1) * 2048 + u.pi * 256 + rt0) * ldc;
#pragma unroll
        for (int ai = 0; ai < 2; ++ai)
#pragma unroll
        for (int m = 0; m < 4; ++m) { bf16_t* rowp = base + (size_t)(ai * HALF + m * 16) * ldc + col0;
#pragma unroll
            for (int bj = 0; bj < 2; ++bj) *(u32x4*)(rowp + bj * HALF) = pack8(acc[ai][bj][m][0] * 0.0009765625f, acc[ai][bj][m][1] * 0.0009765625f); }
    }
};
struct EpiBf16Plain8 {
    static constexpr bool PERM = true, HAS_MID = false, FP8 = true, HALFM = true; static constexpr int MID1 = -1, MID2 = -1;
    bf16_t* O; int ldc; int nNl; bf16_t* part;
    __device__ __forceinline__ void operator()(const f32x4 (&acc)[2][2][4][2], const Unit& u, int wr, int wc, int fr_in, int fq) const {
        int fr = fr_in; asm volatile("" : "+v"(fr)); asm volatile("s_nop 15\n\ts_nop 15\n\ts_nop 15" ::: "memory");
        const int rt0 = wr * 64 + fr, col0 = (u.pn % nNl) * BM + wc * 32 + 8 * fq;
        bf16_t* base = (u.ks == 0) ? O + (size_t)(u.pm * HALF + rt0) * ldc : part + (size_t)((u.ks - 1) * 2048 + u.pi * HALF + rt0) * ldc;
#pragma unroll
        for (int m = 0; m < 4; ++m) { bf16_t* rowp = base + (size_t)(m * 16) * ldc + col0;
#pragma unroll
            for (int bj = 0; bj < 2; ++bj) *(u32x4*)(rowp + bj * HALF) = pack8(acc[0][bj][m][0] * 0.0009765625f, acc[0][bj][m][1] * 0.0009765625f); }
    }
};
template <bool F8> struct EpiInProjT {
    static constexpr bool PERM = true, HAS_MID = false, FP8 = F8, HALFM = false; static constexpr int MID1 = -1, MID2 = -1;
    static constexpr float A8 = F8 ? 0.001953125f : 1.0f;
    bf16_t* P; bf16_t* U2; const float* ropec; const float* ropes; unsigned char* G8;
    __device__ __forceinline__ void operator()(const f32x4 (&acc)[2][2][4][2], const Unit& u, int wr, int wc, int fr_in, int fq) const {
        int fr = fr_in; asm volatile("" : "+v"(fr));
        if constexpr (F8) asm volatile("s_nop 15\n\ts_nop 15\n\ts_nop 15" ::: "memory");
        const int pn = u.pn, row0 = u.pm * BM + wr * 64 + fr;
        if (pn == 10 || pn == 11 || (pn == 12 && wc < 2)) {
            const int cbase = (pn == 12) ? (C_KC + wc * 64) : (C_QC + (pn - 10) * 256 + wc * 64);
            const float sc = ((pn == 12) ? 1.0f : 0.125f) * A8;
#pragma unroll
            for (int ai = 0; ai < 2; ++ai)
#pragma unroll
                for (int m = 0; m < 4; ++m) { const int row = row0 + ai * HALF + m * 16, t = row & (SEQ - 1);
                    f32x4 o1[2], o2[2];
#pragma unroll
                    for (int n = 0; n < 2; ++n) { const f32x4 cs = *(const f32x4*)(ropec + t * 32 + 8 * fq + 4 * n), sn = *(const f32x4*)(ropes + t * 32 + 8 * fq + 4 * n);
                        const f32x4 x1 = acc[ai][0][m][n], x2 = acc[ai][1][m][n];
                        o1[n] = (x1 * cs - x2 * sn) * sc; o2[n] = (x2 * cs + x1 * sn) * sc; }
                    bf16_t* rowp = P + (size_t)row * NIN + cbase + 8 * fq;
                    *(u32x4*)(rowp) = pack8(o1[0], o1[1]); *(u32x4*)(rowp + 32) = pack8(o2[0], o2[1]); }
        } else if (pn == 12) {
#pragma unroll
            for (int ai = 0; ai < 2; ++ai)
#pragma unroll
                for (int m = 0; m < 4; ++m) { bf16_t* rowp = P + (size_t)(row0 + ai * HALF + m * 16) * NIN + C_VC + 32 * (wc - 2) + 8 * fq;
#pragma unroll
                    for (int bj = 0; bj < 2; ++bj) *(u32x4*)(rowp + bj * 64) = pack8(acc[ai][bj][m][0] * A8, acc[ai][bj][m][1] * A8); }
        } else if (pn == 9) {
#pragma unroll
            for (int ai = 0; ai < 2; ++ai)
#pragma unroll
                for (int m = 0; m < 4; ++m) { const int row = row0 + ai * HALF + m * 16, b = row >> 11, t = row & (SEQ - 1), c = t >> 5, s = t & 31;
#pragma unroll
                    for (int bj = 0; bj < 2; ++bj) { const int ch0 = bj * HALF + wc * 32 + 8 * fq, gg = ch0 >> 4, q0 = ch0 & 15;
                        *(u32x4*)(U2 + ((size_t)(gg * S5ROWS + b * S5NC + c)) * S5K + s * 16 + q0) = pack8(acc[ai][bj][m][0] * A8, acc[ai][bj][m][1] * A8); } }
        } else {
            const float sc = ((pn < 3) ? 0.125f : 1.0f) * A8; const bool sg = pn >= 13;
            if (sg) {
#pragma unroll
                for (int ai = 0; ai < 2; ++ai)
#pragma unroll
                    for (int m = 0; m < 4; ++m) { unsigned char* rowp = G8 + (size_t)(row0 + ai * HALF + m * 16) * (3 * DM) + (pn - 13) * BM + (wc * 4 + fq) * 16;
                        u32x2 gw[2];
#pragma unroll
                        for (int bj = 0; bj < 2; ++bj) { f32x4 v0 = acc[ai][bj][m][0], v1 = acc[ai][bj][m][1]; const float c = sc * -1.4426950408889634f;
#pragma unroll
                            for (int j = 0; j < 4; ++j) { v0[j] = __builtin_amdgcn_rcpf(1.0f + __builtin_amdgcn_exp2f(v0[j] * c)); v1[j] = __builtin_amdgcn_rcpf(1.0f + __builtin_amdgcn_exp2f(v1[j] * c)); }
                            gw[bj] = pack8_gate(v0, v1); }
                        __builtin_nontemporal_store((u32x4){gw[0].x, gw[0].y, gw[1].x, gw[1].y}, (u32x4*)rowp); }
            } else {
#pragma unroll
            for (int ai = 0; ai < 2; ++ai)
#pragma unroll
                for (int m = 0; m < 4; ++m) { bf16_t* rowp = P + (size_t)(row0 + ai * HALF + m * 16) * NIN + pn * BM + wc * 32 + 8 * fq;
#pragma unroll
                    for (int bj = 0; bj < 2; ++bj) { f32x4 v0 = acc[ai][bj][m][0] * sc, v1 = acc[ai][bj][m][1] * sc;
                        *(u32x4*)(rowp + bj * HALF) = pack8(v0, v1); } }
            }
        }
    }
};
using EpiInProj = EpiInProjT<false>;
struct EpiBranch {
    static constexpr bool PERM = true, HAS_MID = true, FP8 = false, HALFM = false; static constexpr int MID1 = 4, MID2 = 8;
    const unsigned char* G8; bf16_t* O;
    __device__ __forceinline__ void mid(f32x4 (&acc)[2][2][4][2], const Unit& u, int wr, int wc, int fr, int fq, int which) const {
        int fr_ = fr; asm volatile("" : "+v"(fr_));
        const int row0 = u.pm * BM + wr * 64 + fr_, col0 = u.pn * BM + (wc * 4 + fq) * 16;
        const unsigned char* gp = G8 + (size_t)row0 * (3 * DM) + which * DM + col0;
#pragma unroll
        for (int ai = 0; ai < 2; ++ai) {
            u32x2 wn[4][2], wd[4][2];
#pragma unroll
            for (int m = 0; m < 4; ++m) { const unsigned char* gq = gp + (size_t)(ai * HALF + m * 16) * (3 * DM);
                const u32x4 qn = *(const u32x4*)gq, qd = *(const u32x4*)(gq + DM);
                wn[m][0] = (u32x2){qn.x, qn.y}; wn[m][1] = (u32x2){qn.z, qn.w}; wd[m][0] = (u32x2){qd.x, qd.y}; wd[m][1] = (u32x2){qd.z, qd.w}; }
            asm volatile("" ::: "memory");
#pragma unroll
            for (int m = 0; m < 4; ++m)
#pragma unroll
                for (int bj = 0; bj < 2; ++bj) { f32x4 n0, n1, d0, d1; unpack8_u8(wn[m][bj], n0, n1); unpack8_u8(wd[m][bj], d0, d1);
#pragma unroll
                    for (int j = 0; j < 4; ++j) { acc[ai][bj][m][0][j] *= n0[j] * __builtin_amdgcn_rcpf(d0[j]); acc[ai][bj][m][1][j] *= n1[j] * __builtin_amdgcn_rcpf(d1[j]); } }
            asm volatile("" ::: "memory"); }
    }
    __device__ __forceinline__ void operator()(const f32x4 (&acc)[2][2][4][2], const Unit& u, int wr, int wc, int fr_in, int fq) const {
        int fr = fr_in; asm volatile("" : "+v"(fr));
        const int row0 = u.pm * BM + wr * 64 + fr, col0 = u.pn * BM + wc * 32 + 8 * fq;
        u32x2 wg[2][4][2];
#pragma unroll
        for (int ai = 0; ai < 2; ++ai)
#pragma unroll
            for (int m = 0; m < 4; ++m) { const u32x4 qg = *(const u32x4*)(G8 + (size_t)(row0 + ai * HALF + m * 16) * (3 * DM) + 2 * DM + u.pn * BM + (wc * 4 + fq) * 16);
                wg[ai][m][0] = (u32x2){qg.x, qg.y}; wg[ai][m][1] = (u32x2){qg.z, qg.w}; }
        asm volatile("" ::: "memory");
#pragma unroll
        for (int ai = 0; ai < 2; ++ai)
#pragma unroll
            for (int m = 0; m < 4; ++m) { const int row = row0 + ai * HALF + m * 16;
#pragma unroll
                for (int bj = 0; bj < 2; ++bj) { f32x4 g0, g1; unpack8_u8(wg[ai][m][bj], g0, g1);
                    *(u32x4*)(O + (size_t)row * DM + col0 + bj * HALF) = pack8(acc[ai][bj][m][0] * g0 * (1.0f / 256.0f), acc[ai][bj][m][1] * g1 * (1.0f / 256.0f)); } }
    }
};
struct EpiS5State {
    static constexpr bool PERM = false, HAS_MID = false, FP8 = false, HALFM = true; static constexpr int MID1 = -1, MID2 = -1;
    float* Sst;
    __device__ __forceinline__ void operator()(const f32x4 (&acc)[2][2][4][2], const Unit& u, int wr, int wc, int fr_in, int fq) const {
        int fr = fr_in; asm volatile("" : "+v"(fr));
        const int row0 = u.pm * HALF + wr * 64 + fr, col0 = wc * 32 + 4 * fq;
#pragma unroll
            for (int m = 0; m < 4; ++m) { float* rowp = Sst + (size_t)(row0 + m * 16) * 128 + col0;
#pragma unroll
                for (int n = 0; n < 2; ++n) *(f32x4*)(rowp + n * 16) = acc[0][0][m][n]; }
    }
};
struct EpiS5Main {
    static constexpr bool PERM = true, HAS_MID = false, FP8 = false, HALFM = true; static constexpr int MID1 = -1, MID2 = -1;
    const bf16_t* U2; const float* dskip; bf16_t* gact;
    __device__ __forceinline__ void operator()(const f32x4 (&acc)[2][2][4][2], const Unit& u, int wr, int wc, int fr_in, int fq) const {
        int fr = fr_in; asm volatile("" : "+v"(fr));
        const int gg = u.pm >> 3, rl0 = (u.pm & 7) * HALF + wr * 64 + fr, cl0 = (u.pn & 1) * BM + wc * 32 + 8 * fq;
        u32x4 wu[1][4][2];
        constexpr int ai = 0;
#pragma unroll
            for (int m = 0; m < 4; ++m)
#pragma unroll
                for (int bj = 0; bj < 2; ++bj) wu[ai][m][bj] = *(const u32x4*)(U2 + (size_t)(gg * S5ROWS + rl0 + m * 16) * S5K + cl0 + bj * HALF);
        asm volatile("" ::: "memory");
#pragma unroll
            for (int m = 0; m < 4; ++m) { const int rl = rl0 + m * 16, b = rl >> 6, c = rl & 63;
#pragma unroll
                for (int bj = 0; bj < 2; ++bj) { const int col = cl0 + bj * HALF, tau = col >> 4, p0 = col & 15, ch = gg * 16 + p0;
                    f32x4 u0, u1; unpack8(wu[ai][m][bj], u0, u1);
                    const f32x4 d0 = *(const f32x4*)(dskip + ch), d1 = *(const f32x4*)(dskip + ch + 4);
                    f32x4 y0 = acc[ai][bj][m][0] + d0 * u0, y1 = acc[ai][bj][m][1] + d1 * u1;
#pragma unroll
                    for (int j = 0; j < 4; ++j) { y0[j] = gelu_tanh_f(y0[j]); y1[j] = gelu_tanh_f(y1[j]); }
                    *(u32x4*)(gact + (size_t)(b * SEQ + c * S5T + tau) * 256 + ch) = pack8(y0, y1); } }
    }
};
struct EpiGLU {
    static constexpr bool PERM = true, HAS_MID = false, FP8 = false, HALFM = true; static constexpr int MID1 = -1, MID2 = -1;
    const bf16_t* gact; const float* bglu; bf16_t* ocat;
    __device__ __forceinline__ void operator()(const f32x4 (&acc)[2][2][4][2], const Unit& u, int wr, int wc, int fr_in, int fq) const {
        int fr = fr_in; asm volatile("" : "+v"(fr));
        const int row0 = u.pm * HALF + wr * 64 + fr, col0 = wc * 32 + 8 * fq;
        u32x4 wg[1][4][2];
        constexpr int ai = 0;
#pragma unroll
            for (int m = 0; m < 4; ++m)
#pragma unroll
                for (int bj = 0; bj < 2; ++bj) wg[ai][m][bj] = *(const u32x4*)(gact + (size_t)(row0 + m * 16) * 256 + col0 + bj * HALF);
        asm volatile("" ::: "memory");
#pragma unroll
            for (int m = 0; m < 4; ++m) { const int row = row0 + m * 16;
#pragma unroll
                for (int bj = 0; bj < 2; ++bj) { const int col = col0 + bj * HALF;
                    f32x4 g0, g1; unpack8(wg[ai][m][bj], g0, g1);
                    const f32x4 b0 = *(const f32x4*)(bglu + col), b1 = *(const f32x4*)(bglu + col + 4);
                    f32x4 o0, o1;
#pragma unroll
                    for (int j = 0; j < 4; ++j) { o0[j] = g0[j] * sigmoid_f(acc[ai][bj][m][0][j] + b0[j]); o1[j] = g1[j] * sigmoid_f(acc[ai][bj][m][1][j] + b1[j]); }
                    *(u32x4*)(ocat + (size_t)row * DM + 256 + col) = pack8(o0, o1); } }
    }
};
}

#define XB_TMO      128
#define XB_XCNT(j)  (256  + 64 * (j))
#define XB_XSUB(j)  (1280 + 64 * (j))
#define XB_XGEN(j)  (2304 + 64 * (j))
#define XB_TOP      3328
#define XB_TOPGEN   3392
#define XCD_BAR_WORDS 3456
#define XB_SPIN_CAP (1u << 18)

__device__ __forceinline__ unsigned xb_ld(unsigned* p)              { return __hip_atomic_load(p, __ATOMIC_RELAXED, __HIP_MEMORY_SCOPE_AGENT); }
__device__ __forceinline__ unsigned xb_add(unsigned* p, unsigned v) { return __hip_atomic_fetch_add(p, v, __ATOMIC_RELAXED, __HIP_MEMORY_SCOPE_AGENT); }
__device__ __forceinline__ unsigned xb_xcc_id() { return (unsigned)__builtin_amdgcn_s_getreg((3 << 11) | 20) & 0xFu; }
#define XB_SPIN(cond, bar) do { unsigned _sp = 0; while (cond) { __builtin_amdgcn_s_sleep(1); \
    if ((++_sp & 255u) == 0u) { if (xb_ld(&(bar)[XB_TMO])) break; if (_sp > XB_SPIN_CAP) { atomicAdd(&(bar)[XB_TMO], 1u); break; } } } } while (0)

struct XcdBarrier {
    unsigned* bar; unsigned x;
    volatile LAS unsigned* st;
};
__device__ __forceinline__ XcdBarrier xcd_barrier_post(unsigned* bar, volatile LAS unsigned* st) {
    XcdBarrier b; b.bar = bar; b.x = xb_xcc_id(); b.st = st;
    if (threadIdx.x == 0) (void)xb_add(&bar[XB_XCNT(b.x)], 1u);
    return b;
}
__device__ __forceinline__ void xcd_barrier_complete(unsigned* bar, unsigned x, unsigned& nloc, unsigned& nx) {
    const unsigned G = gridDim.x * gridDim.y * gridDim.z;
    unsigned sum, cnt, mine, sp = 0u;
    for (;;) {
        sum = 0u; cnt = 0u; mine = 0u;
#pragma unroll
        for (unsigned j = 0; j < 16; ++j) { const unsigned c = xb_ld(&bar[XB_XCNT(j)]); sum += c; cnt += (c > 0u) ? 1u : 0u; mine = (j == x) ? c : mine; }
        if (sum == G) break;
        __builtin_amdgcn_s_sleep(1);
        if ((++sp & 255u) == 0u) { if (xb_ld(&bar[XB_TMO])) break; if (sp > XB_SPIN_CAP) { atomicAdd(&bar[XB_TMO], 1u); break; } }
    }
    nloc = mine > 0u ? mine : 1u; nx = cnt > 0u ? cnt : 1u;
}
__device__ __forceinline__ void xcd_barrier(const XcdBarrier& b, const bool leader_thread) {
    asm volatile("s_waitcnt vmcnt(0)" ::: "memory");
    __syncthreads();
    if (leader_thread) {
        unsigned one = 1u; asm volatile("" : "+s"(one));
        unsigned* bar = b.bar;
        __builtin_amdgcn_s_waitcnt(0);
        unsigned nloc = b.st[0], nx = b.st[1];
        if (nloc == 0u) { xcd_barrier_complete(bar, b.x, nloc, nx); b.st[0] = nloc; b.st[1] = nx; }
        const unsigned old = xb_add(&bar[XB_XSUB(b.x)], one);
        const unsigned gen = old / nloc;
        if (old + 1u == (gen + 1u) * nloc) {
            __builtin_amdgcn_fence(__ATOMIC_RELEASE, "agent");
            asm volatile("s_waitcnt vmcnt(0)" ::: "memory");
            const unsigned og = xb_add(&bar[XB_TOP], one);
            const unsigned tg = og / nx;
            if (og + 1u == (tg + 1u) * nx) xb_add(&bar[XB_TOPGEN], one);
            else XB_SPIN(xb_ld(&bar[XB_TOPGEN]) == tg, bar);
            __builtin_amdgcn_fence(__ATOMIC_ACQUIRE, "agent");
            xb_add(&bar[XB_XGEN(b.x)], one);
            asm volatile("s_waitcnt vmcnt(0)" ::: "memory");
        } else {
            XB_SPIN(xb_ld(&bar[XB_XGEN(b.x)]) == gen, bar);
            __builtin_amdgcn_fence(__ATOMIC_ACQUIRE, "agent");
            asm volatile("s_waitcnt vmcnt(0)" ::: "memory");
        }
    }
    __syncthreads();
}

struct Args { const float* in[27]; float* out; unsigned char* ws; int ph_lo, ph_hi; };
enum { I_X = 0, I_NORM_MIX, I_W_IN, I_LAM_RE, I_LAM_IM, I_LOG_DT, I_B_RE, I_B_IM, I_C_RE, I_C_IM, I_S5D, I_WGLU, I_BGLU, I_SINKS, I_WBA, I_WBB, I_WBC, I_WOUT, I_NORM_FFN,
       I_FG, I_FU, I_FD, I_ROUTER, I_MG, I_MU, I_MD, I_NORM_FINAL };

struct Frame {
    LAS unsigned char* lds;
    volatile LAS unsigned* MISC;
    LAS int* moff;
    unsigned* ctl;
    int tid, lane, wave, G, bid;
    unsigned char* ws;
};

__device__ __forceinline__ const float* inptr(const Frame& F, int i) {
    const volatile LAS unsigned* t = (const volatile LAS unsigned*)(F.lds + LDSCTL_OFF + 1024) + 2 * i;
    const unsigned lo = __builtin_amdgcn_readfirstlane(t[0]), hi = __builtin_amdgcn_readfirstlane(t[1]);
    return (const float*)(const GAS float*)(((unsigned long long)hi << 32) | lo);
}
struct TItem { const float* src; bf16_t* dst; int N, ldw; float sc8; };
__device__ __forceinline__ void titem_load(const TItem& t, float (&v)[32], int lane) {
    const float* p = t.src + (size_t)(lane >> 5) * t.N + (lane & 31);
#pragma unroll
    for (int i = 0; i < 32; ++i) v[i] = __builtin_nontemporal_load(p + (size_t)(2 * i) * t.N);
}
__device__ __forceinline__ void titem_store(const TItem& t, const float (&v)[32], LAS float* scr, int lane) {
#pragma unroll
    for (int i = 0; i < 32; ++i) scr[(2 * i + (lane >> 5)) * 33 + (lane & 31)] = v[i];
    LDS_WAIT(); asm volatile("" ::: "memory");
    const int c = lane & 7;
#pragma unroll
    for (int j = 0; j < 4; ++j) { const int n = (lane >> 3) + 8 * j; const LAS float* s = scr + (8 * c) * 33 + n;
        if (t.sc8 != 0.f) { const float q = t.sc8;
            *(u32x2*)((unsigned char*)t.dst + (size_t)n * t.ldw + 8 * c) = pack8_fp8((f32x4){s[0 * 33] * q, s[1 * 33] * q, s[2 * 33] * q, s[3 * 33] * q}, (f32x4){s[4 * 33] * q, s[5 * 33] * q, s[6 * 33] * q, s[7 * 33] * q}); }
        else { u32x4 o; o.x = cvt_pk_bf16(s[0 * 33], s[1 * 33]); o.y = cvt_pk_bf16(s[2 * 33], s[3 * 33]); o.z = cvt_pk_bf16(s[4 * 33], s[5 * 33]); o.w = cvt_pk_bf16(s[6 * 33], s[7 * 33]);
            *(u32x4*)(t.dst + (size_t)n * t.ldw + 8 * c) = o; } }
    LDS_WAIT(); asm volatile("" ::: "memory");
}
template <class Dec>
__device__ __forceinline__ void convert_loop(Frame& F, int NIT, const Dec& dec) {
    LAS float* scr = (LAS float*)(F.lds + F.wave * 8704);
    const int NGW = F.G * NWAVES; int it = F.bid * NWAVES + F.wave;
    if (it >= NIT) return;
    TItem cur = dec(it); float a[32]; titem_load(cur, a, F.lane);
    for (;;) {
        const int nit = it + NGW; const bool has = nit < NIT; TItem nx = cur; float b[32];
        if (has) { nx = dec(nit); titem_load(nx, b, F.lane); }
        titem_store(cur, a, scr, F.lane);
        if (!has) break;
#pragma unroll
        for (int i = 0; i < 32; ++i) a[i] = b[i];
        cur = nx; it = nit;
    }
}
__device__ __forceinline__ int inproj_dest_row(int n0) {
    if (n0 >= C_QC && n0 < C_KC) { const int ub = C_QC + ((n0 - C_QC) >> 8) * 256, r = n0 - ub, hh = r >> 6, half = (r >> 5) & 1; return ub + half * 128 + 32 * hh; }
    if (n0 >= C_KC && n0 < C_VC) { const int r = n0 - C_KC, hh = r >> 6, half = (r >> 5) & 1; return C_KC + half * 128 + 32 * hh; }
    if (n0 >= C_VC && n0 < C_G)  { const int r = n0 - C_VC, hd = r >> 6, j = (r >> 5) & 1; return C_KC + 64 + 128 * hd + 32 * j; }
    return n0;
}
struct MixerDec { const float *win, *wba, *wbb, *wbc, *wout, *wglu; bf16_t *WinT, *WbrT, *WoutT, *WgluT; int in8;
    static constexpr int I_IN = 16 * 200, I_BA = 4 * 32, I_BC = 8 * 32, I_O = 16 * 32, I_GL = 4 * 8, NIT = I_IN + 2 * I_BA + I_BC + I_O + I_GL;
    __device__ __forceinline__ TItem operator()(int it) const { int r = it;
        if (r < I_IN) { const int k0 = 64 * (r / 200), n0 = 32 * (r % 200); return in8 ? TItem{win + (size_t)k0 * NIN + n0, (bf16_t*)((unsigned char*)WinT + (size_t)inproj_dest_row(n0) * DM + k0), NIN, DM, 64.0f}
                                                                                                 : TItem{win + (size_t)k0 * NIN + n0, WinT + (size_t)inproj_dest_row(n0) * DM + k0, NIN, DM, 0.f}; } r -= I_IN;
        if (r < I_BA) { const int k0 = 64 * (r / 32), n0 = 32 * (r % 32); return TItem{wba + (size_t)k0 * DM + n0, WbrT + (size_t)n0 * DM + k0, DM, DM, 0.f}; } r -= I_BA;
        if (r < I_BA) { const int k0 = 64 * (r / 32), n0 = 32 * (r % 32); return TItem{wbb + (size_t)k0 * DM + n0, WbrT + (size_t)n0 * DM + 256 + k0, DM, DM, 0.f}; } r -= I_BA;
        if (r < I_BC) { const int k0 = 64 * (r / 32), n0 = 32 * (r % 32); return TItem{wbc + (size_t)k0 * DM + n0, WbrT + (size_t)n0 * DM + 512 + k0, DM, DM, 0.f}; } r -= I_BC;
        if (r < I_O)  { const int k0 = 64 * (r / 32), n0 = 32 * (r % 32); return TItem{wout + (size_t)k0 * DM + n0, WoutT + (size_t)n0 * DM + k0, DM, DM, 0.f}; } r -= I_O;
        { const int k0 = 64 * (r / 8), n0 = 32 * (r % 8); return TItem{wglu + (size_t)k0 * 256 + n0, WgluT + (size_t)n0 * 256 + k0, 256, 256, 0.f}; } } };
__device__ __forceinline__ void convert_mixer_weights(Frame& F, int l) {
    MixerDec d{inptr(F, I_W_IN) + (size_t)l * DM * NIN, inptr(F, I_WBA) + (size_t)l * 256 * DM, inptr(F, I_WBB) + (size_t)l * 256 * DM, inptr(F, I_WBC) + (size_t)l * 512 * DM,
               inptr(F, I_WOUT) + (size_t)l * DM * DM, inptr(F, I_WGLU) + (size_t)l * 256 * 256,
               (bf16_t*)(F.ws + WS_WIN), (bf16_t*)(F.ws + WS_WBR), (bf16_t*)(F.ws + WS_WOUT), (bf16_t*)(F.ws + WS_WGLU), (IN8_MASK >> l) & 1};
    convert_loop(F, MixerDec::NIT, d);
}
struct FfnDec { const float *Wg, *Wu, *Wd; unsigned char *WguT, *WdT; int es; float sg, sd;
    static constexpr int I_G = 16 * 112, I_D = 56 * 32, I_E = 2 * I_G + I_D;
    __device__ __forceinline__ TItem operator()(int it) const { const int e = it / I_E; int r = it % I_E;
        if (r < I_G) { const int k0 = 64 * (r / 112), n0 = 32 * (r % 112); return TItem{Wg + (size_t)e * DM * DFF + (size_t)k0 * DFF + n0, (bf16_t*)(WguT + ((size_t)(e * 2 * DFF + (n0 >> 7) * 256 + (n0 & 127)) * DM + k0) * es), DFF, es == 1 ? DM : DM, es == 1 ? sg : 0.f}; } r -= I_G;
        if (r < I_G) { const int k0 = 64 * (r / 112), n0 = 32 * (r % 112); return TItem{Wu + (size_t)e * DM * DFF + (size_t)k0 * DFF + n0, (bf16_t*)(WguT + ((size_t)(e * 2 * DFF + (n0 >> 7) * 256 + 128 + (n0 & 127)) * DM + k0) * es), DFF, DM, es == 1 ? sg : 0.f}; } r -= I_G;
        { const int k0 = 64 * (r / 32), n0 = 32 * (r % 32); return TItem{Wd + (size_t)e * DFF * DM + (size_t)k0 * DM + n0, (bf16_t*)(WdT + ((size_t)(e * DM + n0) * DFF + k0) * es), DM, DFF, es == 1 ? sd : 0.f}; } } };
__device__ __forceinline__ void convert_ffn_weights(Frame& F, int l) {
    const bool moe = (l & 1); const int li = l >> 1, ne = moe ? NEXP : 1; const bool f8 = (FP8_MASK >> l) & 1;
    FfnDec d{moe ? inptr(F, I_MG) + (size_t)li * NEXP * DM * DFF : inptr(F, I_FG) + (size_t)li * DM * DFF,
             moe ? inptr(F, I_MU) + (size_t)li * NEXP * DM * DFF : inptr(F, I_FU) + (size_t)li * DM * DFF,
             moe ? inptr(F, I_MD) + (size_t)li * NEXP * DFF * DM : inptr(F, I_FD) + (size_t)li * DFF * DM,
             F.ws + WS_WGU, F.ws + WS_WD, f8 ? 1 : 2, 64.0f, 128.0f};
    convert_loop(F, ne * FfnDec::I_E, d);
}
__device__ __forceinline__ void rope_table(Frame& F) {
    float* rc = (float*)(F.ws + WS_ROPE); float* rs = rc + SEQ * 32;
    for (int idx = F.bid * NTHREADS + F.tid; idx < SEQ * 32; idx += F.G * NTHREADS) { const int t = idx >> 5, i = idx & 31;
        const float inv = exp2f(-(float)i * (17.194602975157967f / 32.0f));
        double rev = (double)t * (double)inv * 0.15915494309189535; rev -= floor(rev); const float rf = (float)rev;
        rc[idx] = __builtin_amdgcn_cosf(rf); rs[idx] = __builtin_amdgcn_sinf(rf); }
}
__device__ __forceinline__ void s5_prep(Frame& F, int l, int gg, int sub) {
    LAS float* apow = (LAS float*)F.lds;
    LAS float* Bb = apow + 33 * 64 * 2;
    LAS float* Cc = Bb + 64 * 16 * 2;
    LAS float* Kt = Cc + 16 * 64 * 2;
    const float* lam_re = inptr(F, I_LAM_RE) + (size_t)(l * 16 + gg) * 64; const float* lam_im = inptr(F, I_LAM_IM) + (size_t)(l * 16 + gg) * 64;
    const float dt = __expf(inptr(F, I_LOG_DT)[l * 16 + gg]);
    const float* bre = inptr(F, I_B_RE) + (size_t)(l * 16 + gg) * 64 * 16; const float* bim = inptr(F, I_B_IM) + (size_t)(l * 16 + gg) * 64 * 16;
    const float* cre = inptr(F, I_C_RE) + (size_t)(l * 16 + gg) * 16 * 64; const float* cim = inptr(F, I_C_IM) + (size_t)(l * 16 + gg) * 16 * 64;
    __syncthreads();
    for (int idx = F.tid; idx < 33 * 64; idx += NTHREADS) { const int k = idx >> 6, n = idx & 63; const float lr = lam_re[n], li = lam_im[n];
        const float mag = __expf(lr * dt * (float)k); double rev = (double)li * (double)dt * (double)k * 0.15915494309189535; rev -= floor(rev); const float rf = (float)rev;
        apow[idx * 2] = mag * __builtin_amdgcn_cosf(rf); apow[idx * 2 + 1] = mag * __builtin_amdgcn_sinf(rf); }
    for (int idx = F.tid; idx < 16 * 64; idx += NTHREADS) { Cc[idx * 2] = cre[idx]; Cc[idx * 2 + 1] = cim[idx]; }
    __syncthreads();
    for (int idx = F.tid; idx < 64 * 16; idx += NTHREADS) { const int n = idx >> 4; const float lr = lam_re[n], li = lam_im[n];
        const float are = apow[(64 + n) * 2], aim = apow[(64 + n) * 2 + 1], nr = are - 1.0f, ni = aim, den = lr * lr + li * li;
        const float zre = (nr * lr + ni * li) / den, zim = (ni * lr - nr * li) / den, br = bre[idx], bi = bim[idx];
        Bb[idx * 2] = zre * br - zim * bi; Bb[idx * 2 + 1] = zre * bi + zim * br; }
    __syncthreads();
    for (int idx = F.tid; idx < 32 * 32; idx += NTHREADS) { const int k = idx >> 5, pl = (idx >> 4) & 1, q = idx & 15, p = 2 * sub + pl; float s = 0.f;
        for (int n = 0; n < 64; ++n) { const float ar = apow[(k * 64 + n) * 2], ai = apow[(k * 64 + n) * 2 + 1], br = Bb[(n * 16 + q) * 2], bi = Bb[(n * 16 + q) * 2 + 1];
            const float tr = ar * br - ai * bi, ti = ar * bi + ai * br; s += Cc[(p * 64 + n) * 2] * tr - Cc[(p * 64 + n) * 2 + 1] * ti; }
        Kt[idx] = s; }
    __syncthreads();
    bf16_t* Toep = (bf16_t*)(F.ws + WS_TOEP) + (size_t)gg * 512 * S5K;
    for (int ci = F.tid; ci < 64 * 80; ci += NTHREADS) { const int rl = ci / 80, cc = ci % 80, t = rl >> 1, pl = rl & 1, p = 2 * sub + pl, row = t * 16 + p; float v[8];
        if (cc < 64) { const int sx = cc >> 1, q0 = (cc & 1) * 8;
#pragma unroll
            for (int j = 0; j < 8; ++j) v[j] = (t >= sx) ? Kt[(t - sx) * 32 + pl * 16 + q0 + j] : 0.f;
        } else { const int c2 = cc - 64, im = c2 >> 3, n0 = (c2 & 7) * 8;
#pragma unroll
            for (int j = 0; j < 8; ++j) { const int n = n0 + j; const float ar = apow[((t + 1) * 64 + n) * 2], ai = apow[((t + 1) * 64 + n) * 2 + 1], cr = Cc[(p * 64 + n) * 2], cim2 = Cc[(p * 64 + n) * 2 + 1];
                v[j] = im ? -(cr * ai + cim2 * ar) : (cr * ar - cim2 * ai); } }
        u32x4 o; o.x = cvt_pk_bf16(v[0], v[1]); o.y = cvt_pk_bf16(v[2], v[3]); o.z = cvt_pk_bf16(v[4], v[5]); o.w = cvt_pk_bf16(v[6], v[7]);
        *(u32x4*)(Toep + (size_t)row * S5K + cc * 8) = o; }
    bf16_t* Em = (bf16_t*)(F.ws + WS_E) + (size_t)gg * 256 * 512;
    for (int ci = F.tid; ci < 32 * 64; ci += NTHREADS) { const int row = 32 * sub + (ci >> 6), cc = ci & 63, sx = cc >> 1, q0 = (cc & 1) * 8; float v[8];
        if (row < 128) { const int im = row >> 6, n = row & 63; const float ar = apow[((31 - sx) * 64 + n) * 2], ai = apow[((31 - sx) * 64 + n) * 2 + 1];
#pragma unroll
            for (int j = 0; j < 8; ++j) { const float br = Bb[(n * 16 + q0 + j) * 2], bi = Bb[(n * 16 + q0 + j) * 2 + 1]; v[j] = im ? (ar * bi + ai * br) : (ar * br - ai * bi); }
        } else {
#pragma unroll
            for (int j = 0; j < 8; ++j) v[j] = 0.f; }
        u32x4 o; o.x = cvt_pk_bf16(v[0], v[1]); o.y = cvt_pk_bf16(v[2], v[3]); o.z = cvt_pk_bf16(v[4], v[5]); o.w = cvt_pk_bf16(v[6], v[7]);
        *(u32x4*)(Em + (size_t)row * 512 + cc * 8) = o; }
    if (sub == 0 && F.tid < 64) { float* aT = (float*)(F.ws + WS_AT) + gg * 128; aT[F.tid * 2] = apow[(32 * 64 + F.tid) * 2]; aT[F.tid * 2 + 1] = apow[(32 * 64 + F.tid) * 2 + 1]; }
    __syncthreads();
}

__device__ __forceinline__ void load_moe_off(Frame& F, int ls) {
    __syncthreads();
    if (F.tid < 8) { int zz = 0; asm volatile("" : "+v"(zz));
        F.moff[16 + F.tid] = (ls & 1) ? (int)__hip_atomic_load(F.ctl + CW_MOECNT + 16 * (ls >> 1) + F.tid, __ATOMIC_RELAXED, __HIP_MEMORY_SCOPE_AGENT) : ((F.tid == 0) ? MTOK + zz : zz); }
    __syncthreads();
    if (F.tid == 0) {
        int o = 0, fp = 0, np = 0; int zz = 0; asm volatile("" : "+v"(zz));
#pragma unroll 1
        for (int e = zz; e < 8; ++e) {
            const int c = F.moff[16 + e];
            F.moff[e] = o; F.moff[24 + e] = fp; o += (c + 255) & ~255; fp += c >> 8;
            if (c & 255) { F.moff[40 + np] = e; F.moff[48 + e] = np; ++np; } else F.moff[48 + e] = zz - 1; }
        F.moff[8] = o; F.moff[32] = fp; F.moff[33] = np;
    }
    __syncthreads();
}

constexpr int NORM_R = 4;
#define NCOL(j) (512 * ((j) >> 1) + 8 * F.lane + 4 * ((j) & 1))
__device__ __forceinline__ void norm_phase(Frame& F, const void* xin_, int xbf, bf16_t* xout, const bf16_t* yb, int add_mode, const float* gain, bf16_t* hout, float* fout,
                                           const float* router, unsigned* gcnt, int* blkcnt = nullptr, int dry_in = 0, int h8 = 0) {
    int dry = dry_in; asm volatile("" : "+s"(dry));
    const int gw = F.bid * NWAVES + F.wave, NGW = F.G * NWAVES;
    const int* toke = (const int*)(F.ws + WS_TOKE); const int* tokp = (const int*)(F.ws + WS_TOKP); const float* tokw = (const float*)(F.ws + WS_TOKW);
    LAS float* rT = (LAS float*)F.lds;
    LAS int* lcnt = (LAS int*)(F.lds + 32768);
    LAS int* rec = (LAS int*)(F.lds + 32768 + 1024);
    if (router) {
        for (int idx = F.tid; idx < DM * NEXP; idx += NTHREADS) rT[(idx & 7) * DM + (idx >> 3)] = router[idx];
        if (F.tid < 64) lcnt[F.tid] = 0;
        __syncthreads();
    }
    f32x4 gn[4];
#pragma unroll
    for (int j = 0; j < 4; ++j) gn[j] = *(const f32x4*)(gain + NCOL(j));
    int iter = 0;
    constexpr int R = NORM_R;
    float eps_l = RMS_EPS; asm volatile("" : "+v"(eps_l));
    for (int m0 = gw * R; m0 < MTOK; m0 += NGW * R) {
        f32x4 v[R][4];
        if (xbf) {
#pragma unroll
            for (int rr = 0; rr < R; ++rr) { const u32x4* xr = (const u32x4*)((const bf16_t*)xin_ + (size_t)(m0 + rr) * DM) + F.lane;
#pragma unroll
                for (int c = 0; c < 2; ++c) { const u32x4 w = __builtin_nontemporal_load(xr + 64 * c); v[rr][2 * c] = (f32x4){bf_lo(w.x), bf_hi(w.x), bf_lo(w.y), bf_hi(w.y)}; v[rr][2 * c + 1] = (f32x4){bf_lo(w.z), bf_hi(w.z), bf_lo(w.w), bf_hi(w.w)}; } }
        } else {
#pragma unroll
        for (int rr = 0; rr < R; ++rr) { const float* xr = (const float*)xin_ + (size_t)(m0 + rr) * DM;
#pragma unroll
            for (int j = 0; j < 4; ++j) v[rr][j] = __builtin_nontemporal_load((const f32x4*)(xr + NCOL(j))); } }
        if (add_mode == 1) {
            u32x4 w[R][2];
#pragma unroll
            for (int rr = 0; rr < R; ++rr) { const u32x4* yr = (const u32x4*)(yb + (size_t)(m0 + rr) * DM) + F.lane;
#pragma unroll
                for (int c = 0; c < 2; ++c) w[rr][c] = __builtin_nontemporal_load(yr + 64 * c); }
#pragma unroll
            for (int rr = 0; rr < R; ++rr)
#pragma unroll
                for (int c = 0; c < 2; ++c) { v[rr][2 * c] += (f32x4){bf_lo(w[rr][c].x), bf_hi(w[rr][c].x), bf_lo(w[rr][c].y), bf_hi(w[rr][c].y)}; v[rr][2 * c + 1] += (f32x4){bf_lo(w[rr][c].z), bf_hi(w[rr][c].z), bf_lo(w[rr][c].w), bf_hi(w[rr][c].w)}; }
        } else if (add_mode == 2) {
            u32x4 wa[R][2], wb[R][2]; float w0[R], w1[R];
#pragma unroll
            for (int rr = 0; rr < R; ++rr) { const int m = m0 + rr; const int e0 = toke[2 * m], e1 = toke[2 * m + 1]; w0[rr] = tokw[2 * m]; w1[rr] = tokw[2 * m + 1];
                const int d0 = F.moff[e0] + tokp[2 * m], d1 = F.moff[e1] + tokp[2 * m + 1];
                const u32x4* y0 = (const u32x4*)(yb + (size_t)d0 * DM) + F.lane; const u32x4* y1 = (const u32x4*)(yb + (size_t)d1 * DM) + F.lane;
#pragma unroll
                for (int c = 0; c < 2; ++c) { wa[rr][c] = __builtin_nontemporal_load(y0 + 64 * c); wb[rr][c] = __builtin_nontemporal_load(y1 + 64 * c); }
            }
#pragma unroll
            for (int rr = 0; rr < R; ++rr)
#pragma unroll
                for (int c = 0; c < 2; ++c) { const u32x4 a = wa[rr][c], b = wb[rr][c];
                    v[rr][2 * c] += (f32x4){bf_lo(a.x), bf_hi(a.x), bf_lo(a.y), bf_hi(a.y)} * w0[rr] + (f32x4){bf_lo(b.x), bf_hi(b.x), bf_lo(b.y), bf_hi(b.y)} * w1[rr];
                    v[rr][2 * c + 1] += (f32x4){bf_lo(a.z), bf_hi(a.z), bf_lo(a.w), bf_hi(a.w)} * w0[rr] + (f32x4){bf_lo(b.z), bf_hi(b.z), bf_lo(b.w), bf_hi(b.w)} * w1[rr]; }
        }
        if (add_mode && !dry && xout) {
#pragma unroll
            for (int rr = 0; rr < R; ++rr) { u32x4* xo = (u32x4*)(xout + (size_t)(m0 + rr) * DM) + F.lane;
#pragma unroll
                for (int c = 0; c < 2; ++c) { u32x4 w; w.x = cvt_pk_bf16(v[rr][2 * c].x, v[rr][2 * c].y); w.y = cvt_pk_bf16(v[rr][2 * c].z, v[rr][2 * c].w); w.z = cvt_pk_bf16(v[rr][2 * c + 1].x, v[rr][2 * c + 1].y); w.w = cvt_pk_bf16(v[rr][2 * c + 1].z, v[rr][2 * c + 1].w);
                    __builtin_nontemporal_store(w, xo + 64 * c); } } }
        float ss[R];
#pragma unroll
        for (int rr = 0; rr < R; ++rr) { ss[rr] = 0.f;
#pragma unroll
            for (int j = 0; j < 4; ++j) ss[rr] += (v[rr][j].x * v[rr][j].x + v[rr][j].y * v[rr][j].y) + (v[rr][j].z * v[rr][j].z + v[rr][j].w * v[rr][j].w); }
#pragma unroll
        for (int o = 1; o < 64; o <<= 1) {
#pragma unroll
            for (int rr = 0; rr < R; ++rr) ss[rr] += shfl_xor_l(ss[rr], o, F.lane); }
#pragma unroll
        for (int rr = 0; rr < R; ++rr) { const float rs = rsqrtf(ss[rr] * (1.0f / DM) + eps_l);
#pragma unroll
            for (int j = 0; j < 4; ++j) v[rr][j] = v[rr][j] * rs * gn[j]; }
        if (dry) { float z = 0.f;
#pragma unroll
            for (int rr = 0; rr < R; ++rr)
#pragma unroll
                for (int j = 0; j < 4; ++j) z += v[rr][j].x + v[rr][j].y + v[rr][j].z + v[rr][j].w;
            if (z == 1.2345e-30f) ((float*)(F.ws + WS_LSE))[0] = z; }
        else if (fout) {
#pragma unroll
            for (int rr = 0; rr < R; ++rr) { float* fo = fout + (size_t)(m0 + rr) * DM;
#pragma unroll
                for (int j = 0; j < 4; ++j) __builtin_nontemporal_store(v[rr][j], (f32x4*)(fo + NCOL(j))); } }
        else if (h8) {
#pragma unroll
            for (int rr = 0; rr < R; ++rr) { u32x2* ho = (u32x2*)((unsigned char*)hout + (size_t)(m0 + rr) * DM) + F.lane;
#pragma unroll
                for (int c = 0; c < 2; ++c) ho[64 * c] = pack8_fp8(v[rr][2 * c] * 8.0f, v[rr][2 * c + 1] * 8.0f); } }
        else {
#pragma unroll
            for (int rr = 0; rr < R; ++rr) { u32x4* ho = (u32x4*)(hout + (size_t)(m0 + rr) * DM) + F.lane;
#pragma unroll
                for (int c = 0; c < 2; ++c) { u32x4 w; w.x = cvt_pk_bf16(v[rr][2 * c].x, v[rr][2 * c].y); w.y = cvt_pk_bf16(v[rr][2 * c].z, v[rr][2 * c].w); w.z = cvt_pk_bf16(v[rr][2 * c + 1].x, v[rr][2 * c + 1].y); w.w = cvt_pk_bf16(v[rr][2 * c + 1].z, v[rr][2 * c + 1].w); ho[64 * c] = w; } } }
        if (router && !dry) {
#pragma unroll
            for (int rr = 0; rr < R; ++rr, ++iter) { const int m = m0 + rr;
                float lg[8];
#pragma unroll
                for (int e = 0; e < 8; ++e) { float s = 0.f;
#pragma unroll
                    for (int j = 0; j < 4; ++j) { const f32x4 r = *(const LAS f32x4*)(rT + e * DM + NCOL(j)); s += (v[rr][j].x * r.x + v[rr][j].y * r.y) + (v[rr][j].z * r.z + v[rr][j].w * r.w); }
                    lg[e] = s; }
#pragma unroll
                for (int o = 1; o < 64; o <<= 1) {
#pragma unroll
                    for (int e = 0; e < 8; ++e) lg[e] += shfl_xor_l(lg[e], o, F.lane); }
                int e0 = 0; float v0 = lg[0];
#pragma unroll
                for (int e = 1; e < 8; ++e) if (lg[e] > v0) { v0 = lg[e]; e0 = e; }
                int e1 = -1; float v1 = -INFINITY;
#pragma unroll
                for (int e = 0; e < 8; ++e) if (e != e0 && lg[e] > v1) { v1 = lg[e]; e1 = e; }
                if (F.lane == 0) { const float w0 = 1.0f / (1.0f + __expf(v1 - v0));
                    float* tw = (float*)(F.ws + WS_TOKW); tw[2 * m] = w0; tw[2 * m + 1] = 1.0f - w0;
                    LAS int* wc_ = lcnt + F.wave * 8; const int r0 = wc_[e0]; wc_[e0] = r0 + 1; const int r1 = wc_[e1]; wc_[e1] = r1 + 1;
                    LAS int* rc = rec + (F.wave * 64 + (iter & 63)) * 4; rc[0] = m; rc[1] = e0 | (e1 << 8); rc[2] = r0; rc[3] = r1; }
            }
        }
    }
    if (router && !dry) {
        LAS int* niter = lcnt + 128;
        if (F.lane == 0) niter[F.wave] = iter;
        __syncthreads();
        if (F.tid < 64) { const int w = F.tid >> 3, e = F.tid & 7; int b = 0; for (int w2 = 0; w2 < w; ++w2) b += lcnt[w2 * 8 + e]; lcnt[64 + F.tid] = b; }
        if (F.tid < 8) { int t = 0; for (int w2 = 0; w2 < 8; ++w2) t += lcnt[w2 * 8 + F.tid];
            blkcnt[F.bid * 8 + F.tid] = t; __hip_atomic_fetch_add(gcnt + F.tid, (unsigned)t, __ATOMIC_RELAXED, __HIP_MEMORY_SCOPE_AGENT); }
        __syncthreads();
        int* te = (int*)(F.ws + WS_TOKE); int* tp = (int*)(F.ws + WS_TOKP);
        { const int w = F.tid >> 6, i = F.tid & 63; if (i < niter[w]) { const LAS int* rc = rec + (w * 64 + i) * 4; const int m = rc[0], e0 = rc[1] & 255, e1 = rc[1] >> 8;
            te[2 * m] = e0; te[2 * m + 1] = e1; tp[2 * m] = lcnt[64 + w * 8 + e0] + rc[2]; tp[2 * m + 1] = lcnt[64 + w * 8 + e1] + rc[3]; } }
        __syncthreads();
    }
}

__device__ __forceinline__ void moe_finalize(Frame& F, const int* blkcnt) {
    LAS int* bb = (LAS int*)(F.lds + 32768);
    __syncthreads();
    { const int e = F.tid & 7, part = F.tid >> 3; int s0 = 0;
#pragma unroll
        for (int k = 0; k < 16; ++k) { const int j = part + 64 * k; if (j < F.bid) s0 += blkcnt[j * 8 + e]; }
        bb[64 + F.tid] = s0; }
    __syncthreads();
    if (F.tid < 8) { int s1 = 0; for (int p = 0; p < 64; ++p) s1 += bb[64 + p * 8 + F.tid]; bb[F.tid] = s1; }
    __syncthreads();
    const int* te = (const int*)(F.ws + WS_TOKE); int* tp = (int*)(F.ws + WS_TOKP); int* trw = (int*)(F.ws + WS_TOKROW);
    const int NGW = F.G * NWAVES;
    for (int idx = F.tid; idx < NWAVES * 64; idx += NTHREADS) { const int w = idx >> 6, i = idx & 63, it = i / NORM_R, rr = i % NORM_R;
        const long m0 = (long)(F.bid * NWAVES + w) * NORM_R + (long)it * NGW * NORM_R; if (m0 >= MTOK) continue; const int m = (int)m0 + rr;
        const int e0 = te[2 * m], e1 = te[2 * m + 1], p0 = bb[e0] + tp[2 * m], p1 = bb[e1] + tp[2 * m + 1];
        tp[2 * m] = p0; tp[2 * m + 1] = p1; trw[(size_t)e0 * MTOK + p0] = m; trw[(size_t)e1 * MTOK + p1] = m; }
}

__device__ __forceinline__ void moe_gather(Frame& F) {
    const int gw = F.bid * NWAVES + F.wave, NGW = F.G * NWAVES;
    const int* toke = (const int*)(F.ws + WS_TOKE); const int* tokp = (const int*)(F.ws + WS_TOKP);
    const bf16_t* h = (const bf16_t*)(F.ws + WS_H); bf16_t* hs = (bf16_t*)(F.ws + WS_Y);
    for (int m = gw; m < MTOK; m += NGW) {
        const u32x4* src = (const u32x4*)(h + (size_t)m * DM) + F.lane; const u32x4 a = src[0], b = src[64];
        const int d0 = F.moff[toke[2 * m]] + tokp[2 * m], d1 = F.moff[toke[2 * m + 1]] + tokp[2 * m + 1];
        u32x4* o0 = (u32x4*)(hs + (size_t)d0 * DM) + F.lane; u32x4* o1 = (u32x4*)(hs + (size_t)d1 * DM) + F.lane;
        o0[0] = a; o0[64] = b; o1[0] = a; o1[64] = b;
    }
}

__device__ __forceinline__ int crow(int r, int hi) { return (r & 3) + 8 * (r >> 2) + 4 * hi; }
__device__ __forceinline__ s16x4 vtr(const LAS unsigned char* p) { return __builtin_bit_cast(s16x4, __builtin_amdgcn_ds_read_tr16_b64_v4i16((LAS v4i16_t*)p)); }
__device__ __forceinline__ void attn_phase(Frame& F, int l, int dry_in = 0) {
    int dry = dry_in; asm volatile("" : "+s"(dry));
    int tid_ = F.tid; asm volatile("" : "+v"(tid_));
    const int hw = F.wave >> 2, sw = F.wave & 3, t256 = tid_ & 255, lane = tid_ & 63, r = lane & 31, h = lane >> 5;
    LAS unsigned char* Kimg = F.lds + hw * 65536; LAS unsigned char* Vimg = Kimg + 32768;
    bf16_t* P = (bf16_t*)(F.ws + WS_PROJ); bf16_t* ocat = (bf16_t*)(F.ws + WS_OCAT); float* lse = (float*)(F.ws + WS_LSE);
    const float LOG2E = 1.4426950408889634f;
    const int rx = (r >> 1) & 7;
    int kofs[4];
#pragma unroll
    for (int ds = 0; ds < 4; ++ds) kofs[ds] = (32 * sw + r) * 128 + (((2 * ds + h) ^ rx) * 16);
    const int gi = lane >> 4, i16 = lane & 15, q = i16 >> 2, p = i16 & 3, xq = (q >> 1) & 1;
    const int vbase = (32 * sw + 4 * h + q) * 128 + ((2 * (gi & 1) + (p >> 1)) * 16) + (p & 1) * 8;
    int vofs[2];
#pragma unroll
    for (int db = 0; db < 2; ++db) vofs[db] = vbase + ((db ^ xq) * 64);
    for (int u = F.bid; u < 2560; u += F.G) {
        const int ub = u & 255, set = (u >> 8) * 8 + (ub & 7), w = (ub >> 3) * 2 + hw;
        int dl, nbk, qcol, kcol, vcol, hd, grp, blk; float sink = -INFINITY; bool isC;
        if (set >= 32) { const int gi = (set - 32) * 4 + (w >> 4); grp = gi >> 6; hd = (gi >> 4) & 3; blk = (gi & 15) * 16 + (w & 15); dl = (grp == 0) ? 1 : (grp == 1 ? 4 : 16); nbk = 16 / dl;
            qcol = C_QA + grp * 256 + hd * 64; kcol = C_KA + grp * 256 + hd * 64; vcol = C_VA + grp * 256 + hd * 64; isC = false; }
        else { grp = 3; hd = (set >> 4) * 4 + (w & 3); blk = (set & 15) * 16 + (w >> 2); dl = 1; nbk = 16; qcol = C_QC + hd * 64; kcol = C_KC + (hd >> 2) * 64; vcol = C_VC + (hd >> 2) * 64; isC = true;
            sink = inptr(F, I_SINKS)[l * 8 + hd]; }
        const int b = blk >> 4, within = blk & 15, ph = within / nbk, nb = within % nbk, tok0 = b * SEQ + ph;
        __syncthreads();
        u32x4 kreg[8], vreg[8];
#pragma unroll
        for (int it = 0; it < 8; ++it) { const int ci = it * 256 + t256, kl = ci >> 3, ch = ci & 7;
            if (nb > 0 || kl >= 128) { const size_t tok = (size_t)tok0 + (size_t)(nb * 128 - 128 + kl) * dl; const bf16_t* rp = P + tok * NIN + ch * 8;
                kreg[it] = *(const u32x4*)(rp + kcol); vreg[it] = *(const u32x4*)(rp + vcol); }
            else { kreg[it] = (u32x4){0u, 0u, 0u, 0u}; vreg[it] = (u32x4){0u, 0u, 0u, 0u}; } }
        const size_t qtok = (size_t)tok0 + (size_t)(nb * 128 + sw * 32 + r) * dl;
        bf16x8 qf[4];
#pragma unroll
        for (int ds = 0; ds < 4; ++ds) qf[ds] = *(const bf16x8*)(P + qtok * NIN + qcol + 16 * ds + 8 * h);
#pragma unroll
        for (int it = 0; it < 8; ++it) { const int ci = it * 256 + t256, kl = ci >> 3, ch = ci & 7;
            *(LAS u32x4*)(Kimg + kl * 128 + ((ch ^ ((kl >> 1) & 7)) * 16)) = kreg[it];
            *(LAS u32x4*)(Vimg + kl * 128 + ((ch ^ ((kl & 2) << 1)) * 16)) = vreg[it]; }
        __syncthreads();
        f32x16 sb[5];
#pragma unroll
        for (int kb = 0; kb < 5; ++kb) {
            const bool valid = (nb > 0) || (sw + kb >= 4);
            f32x16 x;
#pragma unroll
            for (int i = 0; i < 16; ++i) x[i] = 0.f;
            if (valid) {
#pragma unroll
                for (int ds = 0; ds < 4; ++ds) { const bf16x8 kf = *(const LAS bf16x8*)(Kimg + kofs[ds] + kb * 4096); x = __builtin_amdgcn_mfma_f32_32x32x16_bf16(kf, qf[ds], x, 0, 0, 0); }
                if (kb == 0) {
#pragma unroll
                    for (int i = 0; i < 16; ++i) if (crow(i, h) < r) x[i] = -INFINITY; }
                if (kb == 4) {
#pragma unroll
                    for (int i = 0; i < 16; ++i) if (crow(i, h) > r) x[i] = -INFINITY; }
            } else {
#pragma unroll
                for (int i = 0; i < 16; ++i) x[i] = -INFINITY; }
            sb[kb] = x;
        }
        float mx = sink;
#pragma unroll
        for (int kb = 0; kb < 5; ++kb)
#pragma unroll
            for (int i = 0; i < 16; ++i) mx = fmaxf(mx, sb[kb][i]);
        mx = fmaxf(mx, shfl_xor_l(mx, 32, lane));
        float lsum = 0.f; const float nmx = -mx * LOG2E;
#pragma unroll
        for (int kb = 0; kb < 5; ++kb)
#pragma unroll
            for (int i = 0; i < 16; ++i) { const float pv = __builtin_amdgcn_exp2f(__builtin_fmaf(sb[kb][i], LOG2E, nmx)); sb[kb][i] = pv; lsum += pv; }
        lsum += shfl_xor_l(lsum, 32, lane);
        if (isC) lsum += __builtin_amdgcn_exp2f((sink - mx) * LOG2E);
        f32x16 o[2];
#pragma unroll
        for (int db = 0; db < 2; ++db)
#pragma unroll
            for (int i = 0; i < 16; ++i) o[db][i] = 0.f;
#pragma unroll
        for (int kb = 0; kb < 5; ++kb) {
            const bool valid = (nb > 0) || (sw + kb >= 4);
            if (valid) {
#pragma unroll
                for (int s = 0; s < 2; ++s) {
                    u32x4 pw; pw.x = cvt_pk_bf16(sb[kb][8 * s + 0], sb[kb][8 * s + 1]); pw.y = cvt_pk_bf16(sb[kb][8 * s + 2], sb[kb][8 * s + 3]);
                    pw.z = cvt_pk_bf16(sb[kb][8 * s + 4], sb[kb][8 * s + 5]); pw.w = cvt_pk_bf16(sb[kb][8 * s + 6], sb[kb][8 * s + 7]);
                    const bf16x8 pb = __builtin_bit_cast(bf16x8, pw);
#pragma unroll
                    for (int db = 0; db < 2; ++db) {
                        const s16x4 lo = vtr(Vimg + vofs[db] + kb * 4096 + s * 2048), hi = vtr(Vimg + vofs[db] + kb * 4096 + s * 2048 + 1024);
                        const bf16x8 va = (bf16x8){lo[0], lo[1], lo[2], lo[3], hi[0], hi[1], hi[2], hi[3]};
                        o[db] = __builtin_amdgcn_mfma_f32_32x32x16_bf16(va, pb, o[db], 0, 0, 0);
                    }
                }
            }
        }
        const float inv = 1.0f / lsum;
        if (dry) continue;
        bf16_t* op = isC ? (ocat + qtok * DM + 512 + hd * 64) : (P + qtok * NIN + qcol);
#pragma unroll
        for (int db = 0; db < 2; ++db)
#pragma unroll
            for (int ip = 0; ip < 2; ++ip) { u32x2 w[2];
#pragma unroll
                for (int e = 0; e < 2; ++e) { const int ig = 2 * ip + e; w[e].x = cvt_pk_bf16(o[db][4 * ig] * inv, o[db][4 * ig + 1] * inv); w[e].y = cvt_pk_bf16(o[db][4 * ig + 2] * inv, o[db][4 * ig + 3] * inv); }
                unsigned a0 = w[0].x, a1 = w[0].y, b0 = w[1].x, b1 = w[1].y; swap32(a0, b0); swap32(a1, b1);
                *(u32x4*)(op + 32 * db + 16 * ip + 8 * h) = (u32x4){a0, a1, b0, b1}; }
        if (!isC && h == 0) lse[((size_t)grp * MTOK + qtok) * 4 + hd] = mx + __logf(lsum);
    }
    __syncthreads();
}

__device__ __forceinline__ void scan_combine_phase(Frame& F) {
    bf16_t* U2 = (bf16_t*)(F.ws + WS_U2); const float* Sst = (const float*)(F.ws + WS_SST); const float* aTt = (const float*)(F.ws + WS_AT);
    if (F.wave == 0) {
        for (int pr = F.bid; pr < 256; pr += F.G) { const int b = pr >> 4, gg = pr & 15, n = F.lane;
            const float ar = aTt[gg * 128 + 2 * n], ai = aTt[gg * 128 + 2 * n + 1];
            float hr = 0.f, hi = 0.f;
            const size_t row0 = (size_t)gg * S5ROWS + b * S5NC;
#pragma unroll 1
            for (int c0 = 0; c0 < S5NC; c0 += 16) { float sr[16], si[16];
#pragma unroll
                for (int j = 0; j < 16; ++j) { sr[j] = Sst[(row0 + c0 + j) * 128 + n]; si[j] = Sst[(row0 + c0 + j) * 128 + 64 + n]; }
#pragma unroll
                for (int j = 0; j < 16; ++j) { bf16_t* up = U2 + (row0 + c0 + j) * S5K + 512 + n;
                    up[0] = (bf16_t)(cvt_pk_bf16(hr, 0.f) & 0xffffu); up[64] = (bf16_t)(cvt_pk_bf16(hi, 0.f) & 0xffffu);
                    const float nr = ar * hr - ai * hi + sr[j], ni = ar * hi + ai * hr + si[j]; hr = nr; hi = ni; } }
        }
    }
    const bf16_t* P = (const bf16_t*)(F.ws + WS_PROJ); bf16_t* ocat = (bf16_t*)(F.ws + WS_OCAT); const float* lse = (const float*)(F.ws + WS_LSE);
    for (size_t it = (size_t)F.bid * NTHREADS + F.tid; it < (size_t)MTOK * 32; it += (size_t)F.G * NTHREADS) { const size_t tok = it >> 5; const int c8 = (int)(it & 31), hd = c8 >> 3;
        const float l0 = lse[(0 * (size_t)MTOK + tok) * 4 + hd], l1 = lse[(1 * (size_t)MTOK + tok) * 4 + hd], l2 = lse[(2 * (size_t)MTOK + tok) * 4 + hd];
        const float mm = fmaxf(l0, fmaxf(l1, l2)); float w0 = __expf(l0 - mm), w1 = __expf(l1 - mm), w2 = __expf(l2 - mm); const float iv = __builtin_amdgcn_rcpf(w0 + w1 + w2); w0 *= iv; w1 *= iv; w2 *= iv;
        const bf16_t* pp = P + tok * NIN + C_QA + c8 * 8;
        f32x4 a0, a1, b0, b1, c0, c1; unpack8(*(const u32x4*)(pp), a0, a1); unpack8(*(const u32x4*)(pp + 256), b0, b1); unpack8(*(const u32x4*)(pp + 512), c0, c1);
        *(u32x4*)(ocat + tok * DM + c8 * 8) = pack8(a0 * w0 + b0 * w1 + c0 * w2, a1 * w0 + b1 * w1 + c1 * w2); }
}

__device__ __forceinline__ void splitk_reduce(Frame& F) {
    const int np = F.moff[33]; const int gw = F.bid * NWAVES + F.wave, NGW = F.G * NWAVES;
    bf16_t* y = (bf16_t*)(F.ws + WS_Y); const bf16_t* part = (const bf16_t*)(F.ws + WS_YPART);
    for (int it = gw; it < np * 256; it += NGW) { const int pi = it >> 8, r = it & 255, e = F.moff[40 + pi], c = F.moff[16 + e];
        if (r >= (c & 255)) continue;
        u32x2* yr = (u32x2*)(y + (size_t)(F.moff[e] + (c & ~255) + r) * DM) + F.lane;
        u32x2 w[7][4];
#pragma unroll
        for (int j = 0; j < 4; ++j) w[0][j] = yr[64 * j];
#pragma unroll
        for (int ks = 0; ks < 6; ++ks) { const u32x2* pr = (const u32x2*)(part + ((size_t)ks * 2048 + pi * 256 + r) * DM) + F.lane;
#pragma unroll
            for (int j = 0; j < 4; ++j) w[ks + 1][j] = pr[64 * j]; }
#pragma unroll
        for (int j = 0; j < 4; ++j) { f32x4 a = (f32x4){0.f, 0.f, 0.f, 0.f};
#pragma unroll
            for (int ks = 0; ks < 7; ++ks) a += (f32x4){bf_lo(w[ks][j].x), bf_hi(w[ks][j].x), bf_lo(w[ks][j].y), bf_hi(w[ks][j].y)};
            u32x2 o; o.x = cvt_pk_bf16(a[0], a[1]); o.y = cvt_pk_bf16(a[2], a[3]); yr[64 * j] = o; }
    }
}

__global__ void __launch_bounds__(NTHREADS, 2) trunk_fwd(Args args) {
    extern __shared__ __attribute__((aligned(16))) unsigned char lds_raw[];
    Frame F;
    F.lds = (LAS unsigned char*)lds_raw;
    F.MISC = (volatile LAS unsigned*)(F.lds + LDSCTL_OFF + 320);
    F.moff = (LAS int*)(F.lds + LDSCTL_OFF + 512);
    F.tid = threadIdx.x; F.lane = F.tid & 63; F.wave = __builtin_amdgcn_readfirstlane(F.tid >> 6);
    F.G = gridDim.x; F.bid = blockIdx.x; F.ws = args.ws; F.ctl = (unsigned*)(args.ws + WS_CTL);
    for (int u = F.tid; u < (LDS_BYTES - LDSCTL_OFF) / 4; u += NTHREADS) ((LAS unsigned*)(F.lds + LDSCTL_OFF))[u] = 0u;
    __syncthreads();
    if (F.tid == 0) { LAS unsigned long long* tab = (LAS unsigned long long*)(F.lds + LDSCTL_OFF + 1024);
#pragma unroll
        for (int i = 0; i < 27; ++i) tab[i] = (unsigned long long)args.in[i]; }
    __syncthreads();
    const int lo = args.ph_lo, hi = args.ph_hi; const int wave0 = F.wave, bid0 = F.bid, grid0 = F.G; unsigned char* const ws0 = F.ws;
    XcdBarrier bar; bar.bar = F.ctl + CW_BAR; bar.x = 0; bar.st = nullptr;
    if (hi - lo > 1) bar = xcd_barrier_post(F.ctl + CW_BAR, F.MISC + 8);
#define IN(k) (lo <= (k) && (k) < hi)
#define REFRESH() do { int l_; asm volatile("v_mbcnt_lo_u32_b32 %0, -1, 0\n\tv_mbcnt_hi_u32_b32 %0, -1, %0" : "=v"(l_)); F.lane = l_; int w_ = wave0, b_ = bid0, g_ = grid0; unsigned long long p_ = (unsigned long long)ws0; asm volatile("" : "+s"(w_), "+s"(b_), "+s"(g_), "+s"(p_)); F.wave = w_; F.bid = b_; F.G = g_; F.ws = (unsigned char*)(GAS unsigned char*)p_; F.ctl = (unsigned*)(GAS unsigned*)p_; F.tid = w_ * 64 + l_; } while (0)
#define SEAM(k) do { if ((k) + 1 < hi) { REFRESH(); xcd_barrier(bar, F.tid == 0); if (PRB(11)) { REFRESH(); xcd_barrier(bar, F.tid == 0); REFRESH(); xcd_barrier(bar, F.tid == 0); } } } while (0)
#define Hb ((bf16_t*)(F.ws + WS_H))
#define Xb ((bf16_t*)(F.ws + WS_XB))
#define Pb ((bf16_t*)(F.ws + WS_PROJ))
#define Ocat ((bf16_t*)(F.ws + WS_OCAT))
#define Merged ((bf16_t*)(F.ws + WS_MERGED))
#define U2 ((bf16_t*)(F.ws + WS_U2))
#define Sst ((float*)(F.ws + WS_SST))
#define Gact ((bf16_t*)(F.ws + WS_GACT))
#define Hid ((bf16_t*)(F.ws + WS_HID))
#define Yb ((bf16_t*)(F.ws + WS_Y))
#define ropec ((const float*)(F.ws + WS_ROPE))
#define ropes ((const float*)(F.ws + WS_ROPE) + SEQ * 32)

#pragma unroll 1
    for (int l = 0; l < DEPTH; ++l) {
        const int pb = PPL * l; const bool moe = (l & 1);
        if (PHM(0) && IN(pb + 0)) { REFRESH();
            if (l == 0) rope_table(F);
            for (int rep = 0; rep < 1 + PRB(0); ++rep) {
            for (int wi = F.bid; wi < 128; wi += F.G) s5_prep(F, l, wi >> 3, wi & 7);
            convert_mixer_weights(F, l); }
            __syncthreads();
            if (l == 0) { norm_phase(F, inptr(F, I_X), 0, nullptr, nullptr, 0, inptr(F, I_NORM_MIX), Hb, nullptr, nullptr, nullptr, nullptr, 0, IN8_MASK & 1); if (PRB(2)) norm_phase(F, inptr(F, I_X), 0, nullptr, nullptr, 0, inptr(F, I_NORM_MIX), Hb, nullptr, nullptr, nullptr, nullptr, 1); }
            else { load_moe_off(F, l - 1); norm_phase(F, Xb, 1, Xb, Yb, ((l - 1) & 1) ? 2 : 1, inptr(F, I_NORM_MIX) + l * DM, Hb, nullptr, nullptr, nullptr, nullptr, 0, (IN8_MASK >> l) & 1);
                if (PRB(2)) norm_phase(F, Xb, 1, Xb, Yb, ((l - 1) & 1) ? 2 : 1, inptr(F, I_NORM_MIX) + l * DM, Hb, nullptr, nullptr, nullptr, nullptr, 1); }
            SEAM(pb + 0);
        }
        if (PHM(1) && IN(pb + 1)) { REFRESH();
            if ((IN8_MASK >> l) & 1) { REFRESH();
                pg8::Gemm g{Hb, (const bf16_t*)(F.ws + WS_WIN), DM / 2, DM / 2, DM / 2}; pg8::GridOrder S{MTOK / 256, NIN / 256, F.G, F.bid};
                pg8::EpiInProjT<true> E{Pb, U2, ropec, ropes, F.ws + WS_G8};
                pg8::gemm_phase(F.lds, F.tid, g, S, E);
            } else { REFRESH();
            pg8::Gemm g{Hb, (const bf16_t*)(F.ws + WS_WIN), DM, DM, DM}; pg8::GridOrder S{MTOK / 256, NIN / 256, F.G, F.bid};
            pg8::EpiInProj E{Pb, U2, ropec, ropes, F.ws + WS_G8};
            if (PRB(9)) { pg8::EpiBf16Plain E0{Pb, NIN, NIN / 256, nullptr}; pg8::gemm_phase(F.lds, F.tid, g, S, E0); REFRESH(); } pg8::gemm_phase(F.lds, F.tid, g, S, E); if (PRB(4)) { REFRESH(); pg8::gemm_phase(F.lds, F.tid, g, S, E); }
            }
            SEAM(pb + 1);
        }
        if (PHM(2) && IN(pb + 2)) { REFRESH();
            { pg8::Gemm g{U2, (const bf16_t*)(F.ws + WS_E), S5K, 512, 512}; pg8::S5StateOrder S{F.G, F.bid}; pg8::EpiS5State E{Sst}; pg8::gemm_phase(F.lds, F.tid, g, S, E); if (PRB(3)) { REFRESH(); pg8::gemm_phase(F.lds, F.tid, g, S, E); } }
            attn_phase(F, l);
            if (PRB(1)) attn_phase(F, l, 1);
            SEAM(pb + 2);
        }
        if (PHM(3) && IN(pb + 3)) { REFRESH(); scan_combine_phase(F); if (PRB(3)) scan_combine_phase(F); SEAM(pb + 3); }
        if (PHM(4) && IN(pb + 4)) { REFRESH();
            pg8::Gemm g{U2, (const bf16_t*)(F.ws + WS_TOEP), S5K, S5K, S5K}; pg8::S5MainOrder S{F.G, F.bid}; pg8::EpiS5Main E{U2, inptr(F, I_S5D) + l * 256, Gact};
            pg8::gemm_phase(F.lds, F.tid, g, S, E); if (PRB(3)) { REFRESH(); pg8::gemm_phase(F.lds, F.tid, g, S, E); }
            SEAM(pb + 4);
        }
        if (PHM(5) && IN(pb + 5)) { REFRESH();
            pg8::Gemm g{Gact, (const bf16_t*)(F.ws + WS_WGLU), 256, 256, 256}; pg8::GridOrderT<true> S{MTOK / 128, 1, F.G, F.bid}; pg8::EpiGLU E{Gact, inptr(F, I_BGLU) + l * 256, Ocat};
            pg8::gemm_phase(F.lds, F.tid, g, S, E); if (PRB(3)) { REFRESH(); pg8::gemm_phase(F.lds, F.tid, g, S, E); }
            SEAM(pb + 5);
        }
        if (PHM(6) && IN(pb + 6)) { REFRESH();
            pg8::Gemm g{Ocat, (const bf16_t*)(F.ws + WS_WBR), DM, DM, DM}; pg8::GridOrder S{MTOK / 256, DM / 256, F.G, F.bid}; pg8::EpiBranch E{F.ws + WS_G8, Merged};
            pg8::gemm_phase(F.lds, F.tid, g, S, E); if (PRB(5)) { REFRESH(); pg8::gemm_phase(F.lds, F.tid, g, S, E); }
            SEAM(pb + 6);
        }
        if (PHM(7) && IN(pb + 7)) { REFRESH();
            pg8::Gemm g{Merged, (const bf16_t*)(F.ws + WS_WOUT), DM, DM, DM}; pg8::GridOrder S{MTOK / 256, DM / 256, F.G, F.bid}; pg8::EpiBf16Plain E{Hb, DM, DM / 256, nullptr};
            pg8::gemm_phase(F.lds, F.tid, g, S, E); if (PRB(8)) { REFRESH(); pg8::gemm_phase(F.lds, F.tid, g, S, E); }
            SEAM(pb + 7);
        }
        if (PHM(8) && IN(pb + 8)) { REFRESH();
            for (int rep = 0; rep < 1 + PRB(0); ++rep) convert_ffn_weights(F, l);
            __syncthreads();
            norm_phase(F, l == 0 ? (const void*)inptr(F, I_X) : (const void*)Xb, l == 0 ? 0 : 1, Xb, Hb, 1, inptr(F, I_NORM_FFN) + l * DM, ((FP8_MASK >> l) & 1) ? Merged : Hb, nullptr,
                       moe ? inptr(F, I_ROUTER) + (size_t)(l >> 1) * DM * NEXP : nullptr, F.ctl + CW_MOECNT + 16 * (l >> 1), (int*)(F.ws + WS_BLKCNT) + (l >> 1) * 8192, 0, (FP8_MASK >> l) & 1);
            if (PRB(2)) norm_phase(F, Xb, 1, Xb, Hb, 1, inptr(F, I_NORM_FFN) + l * DM, Hb, nullptr, nullptr, nullptr, nullptr, 1);
            SEAM(pb + 8);
        }
        if (PHM(9) && IN(pb + 9) && moe) { REFRESH(); moe_finalize(F, (const int*)(F.ws + WS_BLKCNT) + (l >> 1) * 8192); SEAM(pb + 9); }
        if (PHM(10) && IN(pb + 10)) { REFRESH();
            load_moe_off(F, l);
            const int nT = F.moff[8] >> 8;
            if ((FP8_MASK >> l) & 1) { REFRESH();
#if FP8_FULL
                pg8::Gemm g{Merged, (const bf16_t*)(F.ws + WS_WGU), DM / 2, DM / 2, DM / 2}; pg8::FfnOrderT<true, false> S{nT, 2 * DFF / 256, F.G, F.bid, F.moff, (const int*)(F.ws + WS_TOKROW), moe ? 0 : 1};
                pg8::EpiSwiGLU8F E{F.ws + WS_HID, 2 * DFF / 256};
#else
                pg8::Gemm g{Merged, (const bf16_t*)(F.ws + WS_WGU), DM / 2, DM / 2, DM / 2}; pg8::FfnOrderT<true, true> S{2 * nT, 2 * DFF / 256, F.G, F.bid, F.moff, (const int*)(F.ws + WS_TOKROW), moe ? 0 : 1};
                pg8::EpiSwiGLU8 E{F.ws + WS_HID, 2 * DFF / 256};
#endif
                pg8::gemm_phase(F.lds, F.tid, g, S, E);
            } else { REFRESH();
            pg8::Gemm g{Hb, (const bf16_t*)(F.ws + WS_WGU), DM, DM, DM}; pg8::FfnOrderT<true> S{nT, 2 * DFF / 256, F.G, F.bid, F.moff, (const int*)(F.ws + WS_TOKROW), moe ? 0 : 1}; pg8::EpiSwiGLU E{Hid, 2 * DFF / 256};
            pg8::gemm_phase(F.lds, F.tid, g, S, E); if (PRB(6)) { REFRESH(); pg8::gemm_phase(F.lds, F.tid, g, S, E); }
            }
            SEAM(pb + 10);
        }
        if (PHM(11) && IN(pb + 11)) { REFRESH();
            load_moe_off(F, l);
            const int nT = F.moff[8] >> 8;
            if ((FP8_MASK >> l) & 1) { REFRESH();
#if FP8_FULL
                pg8::Gemm g{Hid, (const bf16_t*)(F.ws + WS_WD), DFF / 2, DFF / 2, DFF / 2}; pg8::FfnDownOrder S{F.G, F.bid, F.moff, pg8::DOWN_KSUB, DFF / 128};
                pg8::EpiBf16Plain8F E{Yb, DM, DM / 256, (bf16_t*)(F.ws + WS_YPART)};
#else
                pg8::Gemm g{Hid, (const bf16_t*)(F.ws + WS_WD), DFF / 2, DFF / 2, DFF / 2}; pg8::FfnDownOrderH S{F.G, F.bid, F.moff, pg8::DOWN_KSUB, DFF / 128};
                pg8::EpiBf16Plain8 E{Yb, DM, DM / 256, (bf16_t*)(F.ws + WS_YPART)};
#endif
                pg8::gemm_phase(F.lds, F.tid, g, S, E);
            } else { REFRESH();
            pg8::Gemm g{Hid, (const bf16_t*)(F.ws + WS_WD), DFF, DFF, DFF}; pg8::FfnDownOrder S{F.G, F.bid, F.moff, pg8::DOWN_KSUB * 2, DFF / 64}; pg8::EpiBf16Plain E{Yb, DM, DM / 256, (bf16_t*)(F.ws + WS_YPART)};
            pg8::gemm_phase(F.lds, F.tid, g, S, E); if (PRB(7)) { REFRESH(); pg8::gemm_phase(F.lds, F.tid, g, S, E); }
            }
            SEAM(pb + 11);
        }
        if (PHM(11) && IN(pb + 12) && moe) { REFRESH(); load_moe_off(F, l); splitk_reduce(F); SEAM(pb + 12); }
    }
    if (PHM(12) && IN(PPL * DEPTH)) { REFRESH(); load_moe_off(F, DEPTH - 1); norm_phase(F, Xb, 1, nullptr, Yb, ((DEPTH - 1) & 1) ? 2 : 1, inptr(F, I_NORM_FINAL), nullptr, args.out, nullptr, nullptr);
        if (PRB(2)) norm_phase(F, Xb, 1, nullptr, Yb, ((DEPTH - 1) & 1) ? 2 : 1, inptr(F, I_NORM_FINAL), nullptr, args.out, nullptr, nullptr, nullptr, 1); }
#undef IN
#undef SEAM
}

extern "C" void kernel_launch(void* const* d_in, const int* in_sizes, int n_in, void* d_out, int out_size, void* d_ws, size_t ws_size, hipStream_t stream) {
    static int grid = 0;
    if (grid == 0) {
        if (n_in != 27 || in_sizes[0] != MTOK * DM || out_size != MTOK * DM || ws_size < WS_END) { fprintf(stderr, "kernel_launch: unexpected shapes (n_in %d, in0 %d, out %d, ws %zu < %zu); nothing launched\n", n_in, n_in > 0 ? in_sizes[0] : -1, out_size, ws_size, (size_t)WS_END); grid = -1; return; }
        int dev = 0, cus = 0, per_cu = 0;
        if (hipGetDevice(&dev) != hipSuccess || hipDeviceGetAttribute(&cus, hipDeviceAttributeMultiprocessorCount, dev) != hipSuccess) { grid = -1; return; }
        if (hipFuncSetAttribute((const void*)trunk_fwd, hipFuncAttributeMaxDynamicSharedMemorySize, LDS_BYTES) != hipSuccess) { fprintf(stderr, "kernel_launch: hipFuncSetAttribute failed\n"); grid = -1; return; }
        if (hipOccupancyMaxActiveBlocksPerMultiprocessor(&per_cu, (const void*)trunk_fwd, NTHREADS, LDS_BYTES) != hipSuccess || per_cu < 1) { fprintf(stderr, "kernel_launch: occupancy query reports %d blocks per CU\n", per_cu); }
        (void)hipGetLastError();
        grid = cus;
    }
    if (grid < 0) return;
    if (hipMemsetAsync((char*)d_ws + WS_CTL, 0, CTL_ZERO_BYTES, stream) != hipSuccess) return;
    Args a{};
    for (int i = 0; i < 27; ++i) a.in[i] = (const float*)d_in[i];
    a.out = (float*)d_out; a.ws = (unsigned char*)d_ws;
#if MK_ONE_LAUNCH
    a.ph_lo = 0; a.ph_hi = NPH;
    hipLaunchKernelGGL(trunk_fwd, dim3(grid), dim3(NTHREADS), LDS_BYTES, stream, a);
#else
    for (int p = 0; p < NPH; ++p) {
        if (p < PPL * DEPTH && ((p % PPL) == 9 || (p % PPL) == 12) && ((p / PPL) & 1) == 0) continue;
        a.ph_lo = p; a.ph_hi = p + 1;
        hipLaunchKernelGGL(trunk_fwd, dim3(grid), dim3(NTHREADS), LDS_BYTES, stream, a);
    }
#endif
}
```
